# Optimizing an MI355X kernel written in HIP

```python
import math
import jax, jax.numpy as jnp
from jax import lax
import numpy as np

D_MODEL = 4096
BATCH = 2
SEQ = 4096
DEPTH = 2

N_A_LAYERS = DEPTH // 2
N_B_LAYERS = DEPTH - N_A_LAYERS

SSM_WIDTH = D_MODEL // 2
SSM_GROUP = 16
SSM_GROUPS = SSM_WIDTH // SSM_GROUP
SSM_STATE = 64
DT_MIN = 1e-3
DT_MAX = 1e-1

N_HEADS = 16
HEAD_DIM = D_MODEL // (2 * N_HEADS)
ATTN_WIDTH = N_HEADS * 2 * HEAD_DIM
Q_BLOCK = 128

N_GROUPS = 4
EXPERTS_PER_GROUP = 4
N_EXPERTS = N_GROUPS * EXPERTS_PER_GROUP
TOP_K_INNER = 2
EXPERT_FF = D_MODEL // 4

EPS = 1e-6

kernel_name = "yoco_s5_diffattn_hmoe"


def rmsnorm(x, g):
    xf = x.astype(jnp.float32)
    y = xf * lax.rsqrt(jnp.mean(xf * xf, axis=-1, keepdims=True) + EPS)
    return (y * g.astype(jnp.float32)).astype(x.dtype)


def s5_mixer(xn, w_in, a_re, a_im, log_dt, b_re, b_im, c_re, c_im, d_skip, w_glu_a, w_glu_b):
    f32 = jnp.float32
    bsz, seq, _ = xn.shape
    u = (xn @ w_in).astype(f32).reshape(bsz, seq, SSM_GROUPS, SSM_GROUP)
    lam_re = a_re.astype(f32)
    lam_im = a_im.astype(f32)
    dt = jnp.exp(log_dt.astype(f32))[:, None]
    mag = jnp.exp(lam_re * dt)
    lb_re = mag * jnp.cos(lam_im * dt)
    lb_im = mag * jnp.sin(lam_im * dt)
    den = lam_re * lam_re + lam_im * lam_im
    nr = lb_re - 1.0
    q_re = (nr * lam_re + lb_im * lam_im) / den
    q_im = (lb_im * lam_re - nr * lam_im) / den
    br = b_re.astype(f32)
    bi = b_im.astype(f32)
    bb_re = q_re[..., None] * br - q_im[..., None] * bi
    bb_im = q_re[..., None] * bi + q_im[..., None] * br
    bu_re = jnp.einsum('blgj,gpj->blgp', u, bb_re)
    bu_im = jnp.einsum('blgj,gpj->blgp', u, bb_im)
    a_re_t = jnp.broadcast_to(lb_re, bu_re.shape)
    a_im_t = jnp.broadcast_to(lb_im, bu_im.shape)

    def combine(e1, e2):
        a1r, a1i, b1r, b1i = e1
        a2r, a2i, b2r, b2i = e2
        return (a2r * a1r - a2i * a1i,
                a2r * a1i + a2i * a1r,
                a2r * b1r - a2i * b1i + b2r,
                a2r * b1i + a2i * b1r + b2i)

    _, _, s_re, s_im = lax.associative_scan(combine, (a_re_t, a_im_t, bu_re, bu_im), axis=1)
    y = (jnp.einsum('blgp,gjp->blgj', s_re, c_re.astype(f32))
         - jnp.einsum('blgp,gjp->blgj', s_im, c_im.astype(f32))
         + d_skip.astype(f32) * u)
    y = jax.nn.gelu(y.reshape(bsz, seq, SSM_WIDTH)).astype(xn.dtype)
    return (y @ w_glu_a) * jax.nn.sigmoid(y @ w_glu_b)


def diff_attention(xn, k, v, w_q, lq1, lk1, lq2, lk2, subln_g, w_o, lambda_init):
    f32 = jnp.float32
    bsz, seq, _ = xn.shape
    n_blocks = seq // Q_BLOCK
    q = (xn @ w_q).reshape(bsz, n_blocks, Q_BLOCK, N_HEADS, 2, HEAD_DIM)
    q = jnp.moveaxis(q, 1, 0)
    lam = (jnp.exp(jnp.sum(lq1.astype(f32) * lk1.astype(f32)))
           - jnp.exp(jnp.sum(lq2.astype(f32) * lk2.astype(f32))) + lambda_init)
    scale = HEAD_DIM ** -0.5
    slopes = 2.0 ** (-8.0 * jnp.arange(1, N_HEADS + 1, dtype=f32) / N_HEADS)
    kpos = jnp.arange(seq, dtype=jnp.int32)

    def block(args):
        qblk, bi = args
        qpos = bi * Q_BLOCK + jnp.arange(Q_BLOCK, dtype=jnp.int32)
        dist = (qpos[:, None] - kpos[None, :]).astype(f32)
        bias = jnp.where(dist >= 0, -slopes[:, None, None] * dist, -jnp.inf)
        s = jnp.einsum('bqhcd,bkhcd->bchqk', qblk, k).astype(f32) * scale + bias
        p = jax.nn.softmax(s, axis=-1)
        w = (p[:, 0] - lam * p[:, 1]).astype(v.dtype)
        return jnp.einsum('bhqk,bkhe->bqhe', w, v)

    o = lax.map(block, (q, jnp.arange(n_blocks, dtype=jnp.int32)))
    o = jnp.moveaxis(o, 0, 1).reshape(bsz, seq, N_HEADS, 2 * HEAD_DIM)
    o = rmsnorm(o, subln_g) * (1.0 - lambda_init)
    return o.reshape(bsz, seq, ATTN_WIDTH) @ w_o


def hier_moe(xn, w_group, b_group, w_router, b_router, w_gate, w_up, w_down):
    f32 = jnp.float32
    bsz, seq, d = xn.shape
    t = xn.reshape(-1, d)
    g_logits = (t @ w_group).astype(f32) + b_group.astype(f32)
    g_prob = jax.nn.softmax(g_logits, axis=-1)
    g_val, g_idx = lax.top_k(g_prob, 1)
    e_logits = ((t @ w_router).astype(f32) + b_router.astype(f32)).reshape(-1, N_GROUPS, EXPERTS_PER_GROUP)
    e_sel = jnp.take_along_axis(e_logits, g_idx[:, :, None], axis=1)[:, 0]
    top_v, top_i = lax.top_k(e_sel, TOP_K_INNER)
    top_w = jax.nn.softmax(top_v, axis=-1) * g_val
    expert_id = g_idx * EXPERTS_PER_GROUP + top_i
    gates = jnp.sum(jax.nn.one_hot(expert_id, N_EXPERTS, dtype=f32) * top_w[..., None], axis=1)
    h = jax.nn.silu(jnp.einsum('td,edf->tef', t, w_gate)) * jnp.einsum('td,edf->tef', t, w_up)
    y = jnp.einsum('tef,efd->td', h * gates[:, :, None].astype(h.dtype), w_down)
    return y.reshape(bsz, seq, d)


def setup_inputs(seed: int = 0) -> dict:
    key = jax.random.key(seed)
    ks = iter(jax.random.split(key, 40))
    f32 = jnp.float32

    def nrm(shape, scale):
        return jax.random.normal(next(ks), shape, f32) * scale

    def gain(shape):
        return jnp.ones(shape, f32) + nrm(shape, 0.01)

    na, nb = N_A_LAYERS, N_B_LAYERS
    n_idx = jnp.arange(SSM_STATE, dtype=f32)
    return {
        "x": nrm((BATCH, SEQ, D_MODEL), 1.0),
        "ssm_w_in": nrm((na, D_MODEL, SSM_WIDTH), D_MODEL ** -0.5),
        "ssm_a_re": -0.5 + nrm((na, SSM_GROUPS, SSM_STATE), 0.01),
        "ssm_a_im": math.pi * n_idx + nrm((na, SSM_GROUPS, SSM_STATE), 0.01),
        "ssm_log_dt": jax.random.uniform(next(ks), (na, SSM_GROUPS), f32, math.log(DT_MIN), math.log(DT_MAX)),
        "ssm_b_re": nrm((na, SSM_GROUPS, SSM_STATE, SSM_GROUP), SSM_GROUP ** -0.5),
        "ssm_b_im": nrm((na, SSM_GROUPS, SSM_STATE, SSM_GROUP), SSM_GROUP ** -0.5),
        "ssm_c_re": nrm((na, SSM_GROUPS, SSM_GROUP, SSM_STATE), SSM_STATE ** -0.5),
        "ssm_c_im": nrm((na, SSM_GROUPS, SSM_GROUP, SSM_STATE), SSM_STATE ** -0.5),
        "ssm_d": nrm((na, SSM_GROUPS, SSM_GROUP), 1.0),
        "ssm_w_glu_a": nrm((na, SSM_WIDTH, D_MODEL), SSM_WIDTH ** -0.5),
        "ssm_w_glu_b": nrm((na, SSM_WIDTH, D_MODEL), SSM_WIDTH ** -0.5),
        "kv_norm_g": gain((D_MODEL,)),
        "w_k": nrm((D_MODEL, ATTN_WIDTH), D_MODEL ** -0.5),
        "w_v": nrm((D_MODEL, ATTN_WIDTH), D_MODEL ** -0.5),
        "attn_w_q": nrm((nb, D_MODEL, ATTN_WIDTH), D_MODEL ** -0.5),
        "attn_lambda_q1": nrm((nb, HEAD_DIM), 0.1),
        "attn_lambda_k1": nrm((nb, HEAD_DIM), 0.1),
        "attn_lambda_q2": nrm((nb, HEAD_DIM), 0.1),
        "attn_lambda_k2": nrm((nb, HEAD_DIM), 0.1),
        "attn_subln_g": gain((nb, 2 * HEAD_DIM)),
        "attn_w_o": nrm((nb, ATTN_WIDTH, D_MODEL), ATTN_WIDTH ** -0.5),
        "moe_w_group": nrm((DEPTH, D_MODEL, N_GROUPS), D_MODEL ** -0.5),
        "moe_b_group": nrm((DEPTH, N_GROUPS), 0.01),
        "moe_w_router": nrm((DEPTH, D_MODEL, N_EXPERTS), D_MODEL ** -0.5),
        "moe_b_router": nrm((DEPTH, N_EXPERTS), 0.01),
        "moe_w_gate": nrm((DEPTH, N_EXPERTS, D_MODEL, EXPERT_FF), D_MODEL ** -0.5),
        "moe_w_up": nrm((DEPTH, N_EXPERTS, D_MODEL, EXPERT_FF), D_MODEL ** -0.5),
        "moe_w_down": nrm((DEPTH, N_EXPERTS, EXPERT_FF, D_MODEL), EXPERT_FF ** -0.5),
        "norm_mix_g": gain((DEPTH, D_MODEL)),
        "norm_ffn_g": gain((DEPTH, D_MODEL)),
        "final_norm_g": gain((D_MODEL,)),
    }


def reference(x, ssm_w_in, ssm_a_re, ssm_a_im, ssm_log_dt, ssm_b_re, ssm_b_im, ssm_c_re, ssm_c_im,
              ssm_d, ssm_w_glu_a, ssm_w_glu_b, kv_norm_g, w_k, w_v, attn_w_q, attn_lambda_q1,
              attn_lambda_k1, attn_lambda_q2, attn_lambda_k2, attn_subln_g, attn_w_o, moe_w_group,
              moe_b_group, moe_w_router, moe_b_router, moe_w_gate, moe_w_up, moe_w_down,
              norm_mix_g, norm_ffn_g, final_norm_g):
    bsz, seq, _ = x.shape
    h = x
    k_shared = None
    v_shared = None
    for li in range(DEPTH):
        hn = rmsnorm(h, norm_mix_g[li])
        if li < N_A_LAYERS:
            a = li
            h = h + s5_mixer(hn, ssm_w_in[a], ssm_a_re[a], ssm_a_im[a], ssm_log_dt[a], ssm_b_re[a],
                             ssm_b_im[a], ssm_c_re[a], ssm_c_im[a], ssm_d[a], ssm_w_glu_a[a], ssm_w_glu_b[a])
        else:
            b = li - N_A_LAYERS
            lambda_init = 0.8 - 0.6 * math.exp(-0.3 * li)
            h = h + diff_attention(hn, k_shared, v_shared, attn_w_q[b], attn_lambda_q1[b], attn_lambda_k1[b],
                                   attn_lambda_q2[b], attn_lambda_k2[b], attn_subln_g[b], attn_w_o[b], lambda_init)
        h = h + hier_moe(rmsnorm(h, norm_ffn_g[li]), moe_w_group[li], moe_b_group[li], moe_w_router[li],
                         moe_b_router[li], moe_w_gate[li], moe_w_up[li], moe_w_down[li])
        if li == N_A_LAYERS - 1:
            kvn = rmsnorm(h, kv_norm_g)
            k_shared = (kvn @ w_k).reshape(bsz, seq, N_HEADS, 2, HEAD_DIM)
            v_shared = (kvn @ w_v).reshape(bsz, seq, N_HEADS, 2 * HEAD_DIM)
    return rmsnorm(h, final_norm_g)
```

```cpp
#define DOUBLE_BARRIER 2
#include <hip/hip_runtime.h>
#include <cstdio>
#include <cstdint>

#define LAS __attribute__((address_space(3)))
#define GAS __attribute__((address_space(1)))
typedef unsigned short bf16_t;
typedef short bf16x8 __attribute__((ext_vector_type(8)));
typedef short s16x4 __attribute__((ext_vector_type(4)));
typedef float f32x4 __attribute__((ext_vector_type(4)));
typedef float f32x2 __attribute__((ext_vector_type(2)));
typedef float f32x16 __attribute__((ext_vector_type(16)));
typedef unsigned u32x4 __attribute__((ext_vector_type(4)));
typedef unsigned u32x2 __attribute__((ext_vector_type(2)));

constexpr int BATCH = 2, SEQ = 4096, T = BATCH * SEQ, DM = 4096;
constexpr int SW = 2048, NG = 128, SJ = 16, SP = 64;
constexpr int NH = 16, HD = 128, AW = 4096;
constexpr int NE = 16, FF = 1024;
constexpr float EPS = 1e-6f;
constexpr float LAMBDA_INIT1 = 0.35550906759f;
constexpr int NSEG = 8, LSEG = SEQ / NSEG;

constexpr size_t MiB = 1u << 20;
constexpr size_t WS_CTL = 0, CTL_ZERO_BYTES = 1 * MiB;
constexpr size_t WS_WIN = 16 * MiB;
constexpr size_t WS_GLU = 32 * MiB;
constexpr size_t WS_QKV = 64 * MiB;
constexpr size_t WS_WO = 160 * MiB;
constexpr size_t WS_GU = 192 * MiB;
constexpr size_t WS_DN = 704 * MiB;
constexpr size_t WS_WRT = 960 * MiB;
constexpr size_t WS_RSTD = 961 * MiB;
constexpr size_t WS_LIST = 962 * MiB;
constexpr size_t WS_ENDS = 963 * MiB;
constexpr size_t WS_XB = 964 * MiB;
constexpr size_t WS_UB = 1028 * MiB;
constexpr size_t WS_YB = 1060 * MiB;
constexpr size_t WS_H = 1092 * MiB;
constexpr size_t WS_Q = 1220 * MiB;
constexpr size_t WS_OC = 1412 * MiB;
constexpr size_t WS_OB = 1540 * MiB;
constexpr size_t WS_YS = 1604 * MiB;
constexpr size_t WS_HM = 1732 * MiB;
constexpr size_t WS_END = 1772 * MiB;
constexpr int CW_BAR = 4096;
constexpr int CW_CNT = 16384;
constexpr int LISTCAP = 8192;

constexpr int RING_BYTES = 131072;
constexpr int MISC_OFF = RING_BYTES;
constexpr int TAB_OFF = RING_BYTES + 256;
constexpr int LDS_BYTES = 163840;
constexpr int NWAVES = 8;

#define LDS_WAIT() asm volatile("s_waitcnt lgkmcnt(0)" ::: "memory")
#define VM_WAIT() asm volatile("s_waitcnt vmcnt(0)" ::: "memory")
__device__ __forceinline__ unsigned f2bf(float f) { unsigned u = __builtin_bit_cast(unsigned, f); return (u + 0x7fffu + ((u >> 16) & 1u)) >> 16; }
__device__ __forceinline__ float bf2f(unsigned b) { return __builtin_bit_cast(float, b << 16); }
__device__ __forceinline__ unsigned cvt_pk_bf16(float lo, float hi) { unsigned r; asm volatile("v_cvt_pk_bf16_f32 %0, %1, %2" : "=v"(r) : "v"(lo), "v"(hi)); return r; }
__device__ __forceinline__ float wave_sum(float v) {
#pragma unroll
    for (int o = 1; o < 64; o <<= 1) v += __shfl_xor(v, o);
    return v;
}
__device__ __forceinline__ int tid_opaque() { int t = threadIdx.x; asm volatile("" : "+v"(t)); return t; }
__device__ __forceinline__ int bid_opaque() { int b = blockIdx.x; asm volatile("" : "+s"(b)); return b; }
__device__ __forceinline__ int grid_opaque() { int g = gridDim.x; asm volatile("" : "+s"(g)); return g; }
__device__ __forceinline__ float ld_coh(const float* p) { return __builtin_bit_cast(float, __hip_atomic_load((const unsigned*)p, __ATOMIC_RELAXED, __HIP_MEMORY_SCOPE_AGENT)); }
__device__ __forceinline__ int ld_coh(const int* p) { return (int)__hip_atomic_load((const unsigned*)p, __ATOMIC_RELAXED, __HIP_MEMORY_SCOPE_AGENT); }
__device__ __forceinline__ void st_coh(float* p, float v) { __hip_atomic_store((unsigned*)p, __builtin_bit_cast(unsigned, v), __ATOMIC_RELAXED, __HIP_MEMORY_SCOPE_AGENT); }
__device__ __forceinline__ void st_coh(int* p, int v) { __hip_atomic_store((unsigned*)p, (unsigned)v, __ATOMIC_RELAXED, __HIP_MEMORY_SCOPE_AGENT); }
__device__ __forceinline__ void st16_wt(void* p, u32x4 v) { asm volatile("global_store_dwordx4 %0, %1, off sc1\n\ts_nop 1" :: "v"(p), "v"(v) : "memory"); }
__device__ __forceinline__ void st16_wt(void* p, f32x4 v) { st16_wt(p, __builtin_bit_cast(u32x4, v)); }
__device__ __forceinline__ void st8_wt(void* p, u32x2 v) { asm volatile("global_store_dwordx2 %0, %1, off sc1\n\ts_nop 1" :: "v"(p), "v"(v) : "memory"); }
__device__ __forceinline__ void st4_wt(void* p, unsigned v) { asm volatile("global_store_dword %0, %1, off sc1\n\ts_nop 1" :: "v"(p), "v"(v) : "memory"); }
__device__ __forceinline__ void st2_wt(void* p, unsigned v) { asm volatile("global_store_short %0, %1, off sc1\n\ts_nop 1" :: "v"(p), "v"(v) : "memory"); }
__device__ __forceinline__ float fast_sigmoid(float x) { return __builtin_amdgcn_rcpf(1.0f + __expf(-x)); }

#define XB_TMO      128
#define XB_XCNT(j)  (256  + 64 * (j))
#define XB_XSUB(j)  (1280 + 64 * (j))
#define XB_XGEN(j)  (2304 + 64 * (j))
#define XB_TOP      3328
#define XB_TOPGEN   3392
#define XCD_BAR_WORDS 3456
#define XB_SPIN_CAP (1u << 18)
__device__ __forceinline__ unsigned xb_ld(unsigned* p)              { return __hip_atomic_load(p, __ATOMIC_RELAXED, __HIP_MEMORY_SCOPE_AGENT); }
__device__ __forceinline__ unsigned xb_add(unsigned* p, unsigned v) { return __hip_atomic_fetch_add(p, v, __ATOMIC_RELAXED, __HIP_MEMORY_SCOPE_AGENT); }
__device__ __forceinline__ unsigned xb_xcc_id() { return (unsigned)__builtin_amdgcn_s_getreg((3 << 11) | 20) & 0xFu; }
#define XB_SPIN(cond, bar) do { unsigned _sp = 0; while (cond) { __builtin_amdgcn_s_sleep(1); \
    if ((++_sp & 255u) == 0u) { if (xb_ld(&(bar)[XB_TMO])) break; if (_sp > XB_SPIN_CAP) { atomicAdd(&(bar)[XB_TMO], 1u); break; } } } } while (0)
struct XcdBarrier { unsigned* bar; unsigned x; volatile LAS unsigned* st; };
__device__ __forceinline__ XcdBarrier xcd_barrier_post(unsigned* bar, volatile LAS unsigned* st) {
    XcdBarrier b; b.bar = bar; b.x = xb_xcc_id(); b.st = st;
    if (threadIdx.x == 0) (void)xb_add(&bar[XB_XCNT(b.x)], 1u);
    return b;
}
__device__ __forceinline__ void xcd_barrier_complete(unsigned* bar, unsigned x, unsigned& nloc, unsigned& nx) {
    const unsigned G = gridDim.x * gridDim.y * gridDim.z;
    unsigned sum, cnt, mine, sp = 0u;
    for (;;) {
        sum = 0u; cnt = 0u; mine = 0u;
#pragma unroll
        for (unsigned j = 0; j < 16; ++j) { const unsigned c = xb_ld(&bar[XB_XCNT(j)]); sum += c; cnt += (c > 0u) ? 1u : 0u; mine = (j == x) ? c : mine; }
        if (sum == G) break;
        __builtin_amdgcn_s_sleep(1);
        if ((++sp & 255u) == 0u) { if (xb_ld(&bar[XB_TMO])) break; if (sp > XB_SPIN_CAP) { atomicAdd(&bar[XB_TMO], 1u); break; } }
    }
    nloc = mine > 0u ? mine : 1u; nx = cnt > 0u ? cnt : 1u;
}
__device__ __forceinline__ void xcd_barrier(const XcdBarrier& b) {
    asm volatile("s_waitcnt vmcnt(0)" ::: "memory");
    __syncthreads();
    if (threadIdx.x == 0) {
        unsigned* bar = b.bar;
        __builtin_amdgcn_s_waitcnt(0);
        unsigned nloc = b.st[0], nx = b.st[1];
        if (nloc == 0u) { xcd_barrier_complete(bar, b.x, nloc, nx); b.st[0] = nloc; b.st[1] = nx; }
        const unsigned old = xb_add(&bar[XB_XSUB(b.x)], 1u);
        const unsigned gen = old / nloc;
        if (old + 1u == (gen + 1u) * nloc) {
            __builtin_amdgcn_fence(__ATOMIC_RELEASE, "");
            asm volatile("s_waitcnt vmcnt(0)" ::: "memory");
            const unsigned og = xb_add(&bar[XB_TOP], 1u);
            const unsigned tg = og / nx;
            if (og + 1u == (tg + 1u) * nx) xb_add(&bar[XB_TOPGEN], 1u);
            else XB_SPIN(xb_ld(&bar[XB_TOPGEN]) == tg, bar);
            __builtin_amdgcn_fence(__ATOMIC_ACQUIRE, "");
            xb_add(&bar[XB_XGEN(b.x)], 1u);
            asm volatile("s_waitcnt vmcnt(0)" ::: "memory");
        } else {
            XB_SPIN(xb_ld(&bar[XB_XGEN(b.x)]) == gen, bar);
            __builtin_amdgcn_fence(__ATOMIC_ACQUIRE, "");
            asm volatile("s_waitcnt vmcnt(0)" ::: "memory");
        }
    }
    __syncthreads();
}

namespace pg8 {
constexpr int BM = 256, BK = 64, HALF = 128, HTB = HALF * BK * 2, NXCD = 8, WGM = 8;
__device__ __forceinline__ int lds_byte(int r, int c) { const int st = (r >> 4) * 2 + (c >> 5), rr = r & 15, cc = c & 31, ob = rr * 64 + cc * 2; return st * 1024 + (ob ^ (((ob >> 9) & 1) << 5)); }
__device__ __forceinline__ void stage_rc(int b, int& R, int& C) { const int st = b / 1024, sb = b % 1024, swz = sb ^ (((sb >> 9) & 1) << 5); R = (st >> 1) * 16 + swz / 64; C = (st & 1) * 32 + (swz % 64) / 2; }
__device__ __forceinline__ int perm32(int rho) { const int n = rho >> 4, i = rho & 15; return 8 * (i >> 2) + 4 * n + (i & 3); }
struct Unit { int pm, pn, bt; };
__device__ __forceinline__ void tile_of(int L, int nM, int nN, int& pm, int& pn) {
    const int nwg = nM * nN; int wgid = L;
    { const int q = nwg / NXCD, r = nwg % NXCD, xcd = wgid % NXCD, off = wgid / NXCD; wgid = (xcd < r ? xcd * (q + 1) : r * (q + 1) + (xcd - r) * q) + off; }
    const int nig = WGM * nN, gid = wgid / nig, fm = gid * WGM, gsz = (nM - fm) < WGM ? (nM - fm) : WGM;
    pm = fm + ((wgid % nig) % gsz); pn = (wgid % nig) / gsz;
}
struct StaticOrder {
    int nM, nN, nwg, G, c;
    __device__ void init(int M, int N, int G_, int c_) { nM = M / BM; nN = N / BM; nwg = nM * nN; G = G_; c = c_; }
    __device__ __forceinline__ bool next(int i, Unit& u) const {
        const long L = (long)i * G + c; if (L >= nwg) return false;
        tile_of((int)L, nM, nN, u.pm, u.pn); u.bt = u.pn; return true;
    }
};
struct ListOrder {
    const LAS int* ul; int n;
    __device__ __forceinline__ bool next(int i, Unit& u) const {
        if (i >= n) return false;
        u.pm = __builtin_amdgcn_readfirstlane(ul[3 * i]); u.pn = __builtin_amdgcn_readfirstlane(ul[3 * i + 1]); u.bt = __builtin_amdgcn_readfirstlane(ul[3 * i + 2]); return true;
    }
};

template <class Epi, class Sched, bool GATHER>
__device__ __forceinline__ void gemm_phase(LAS unsigned char* lds, const bf16_t* Abase, const bf16_t* Btbase, const int K, const Sched& S, const Epi& E, const LAS unsigned* gtab) {
    const int tid = tid_opaque(), wid = __builtin_amdgcn_readfirstlane(tid >> 6), lane = tid & 63, wr = wid >> 2, wc = wid & 3, fr = lane & 15, fq = lane >> 4;
    const int nt = K / BK;
    unsigned voffA[2], voffB[2]; int RA[2], CA2[2];
#pragma unroll
    for (int i = 0; i < 2; ++i) { int R, C; stage_rc(tid * 16 + i * 8192, R, C); const int Rb = Epi::PERM ? ((R & ~31) + perm32(R & 31)) : R;
        voffA[i] = (unsigned)(R * K + C) * 2u; voffB[i] = (unsigned)(Rb * K + C) * 2u; RA[i] = R; CA2[i] = C * 2; }
    const size_t kstep = (size_t)(BK * 2);
    const size_t hstep = (size_t)HALF * K * 2;
    const size_t tstep = 2 * hstep;
    const unsigned ldsw = (unsigned)wid * 1024u;
    const int aoff = lds_byte(wr * 64 + fr, fq * 8), boff = lds_byte(wc * 32 + fr, fq * 8);
#define PG8_SA(b, h) (((b) * 2 + (h)) * HTB)
#define PG8_SB(b, h) ((4 + (b) * 2 + (h)) * HTB)
#define PG8_STAGE(bufoff, gbase, voff) do { _Pragma("unroll") for (int _i = 0; _i < 2; ++_i) \
        __builtin_amdgcn_global_load_lds((const unsigned*)((const char*)(gbase) + (voff)[_i]), (LAS unsigned*)(lds + (bufoff) + ldsw + _i * 8192), 16, 0, 0); } while (0)
#define PG8_STGA(bufoff, ptr, h, goff) do { if constexpr (GATHER) { PG8_STAGE(bufoff, ptr, goff[h]); } else { PG8_STAGE(bufoff, (ptr) + (h) * hstep, voffA); } } while (0)
#define PG8_LDA(dst, b, h) do { _Pragma("unroll") for (int m = 0; m < 4; ++m) _Pragma("unroll") for (int k = 0; k < 2; ++k) dst[m][k] = *(const LAS bf16x8*)(lds + PG8_SA(b, h) + aoff + m * 2048 + k * 1024); } while (0)
#define PG8_LDB(dst, b, h) do { _Pragma("unroll") for (int n = 0; n < 2; ++n) _Pragma("unroll") for (int k = 0; k < 2; ++k) dst[n][k] = *(const LAS bf16x8*)(lds + PG8_SB(b, h) + boff + n * 2048 + k * 1024); } while (0)
#define PG8_MMA(ai, bj, At, Bt) do { __builtin_amdgcn_s_setprio(1); _Pragma("unroll") for (int m = 0; m < 4; ++m) _Pragma("unroll") for (int n = 0; n < 2; ++n) _Pragma("unroll") for (int k = 0; k < 2; ++k) \
        acc[ai][bj][m][n] = __builtin_amdgcn_mfma_f32_16x16x32_bf16(Bt[n][k], At[m][k], acc[ai][bj][m][n], 0, 0, 0); __builtin_amdgcn_s_setprio(0); } while (0)
#define PG8_WAIT_V(n) asm volatile("s_waitcnt vmcnt(" #n ")" ::: "memory")
#define PG8_WAIT_L(n) asm volatile("s_waitcnt lgkmcnt(" #n ")" ::: "memory")
#define PG8_BAR __builtin_amdgcn_s_barrier()
#define PG8_SCHED __builtin_amdgcn_sched_barrier(0)
    Unit cur, nxt; int ui = 0;
    if (!S.next(0, cur)) return;
    f32x4 acc[2][2][4][2];
#pragma unroll
    for (int a = 0; a < 2; ++a)
#pragma unroll
        for (int b = 0; b < 2; ++b)
#pragma unroll
            for (int m = 0; m < 4; ++m)
#pragma unroll
                for (int n = 0; n < 2; ++n) acc[a][b][m][n] = (f32x4){0.f, 0.f, 0.f, 0.f};
    bf16x8 At[4][2], B0[2][2], B1[2][2];
    unsigned gC[2][2], gN[2][2];
    if constexpr (GATHER) {
#pragma unroll
        for (int h = 0; h < 2; ++h)
#pragma unroll
            for (int i = 0; i < 2; ++i) { gC[h][i] = gtab[0 * 256 + h * HALF + RA[i]] + (unsigned)CA2[i]; gN[h][i] = gC[h][i]; }
    }
    const char* cA = GATHER ? (const char*)Abase : (const char*)Abase + (size_t)cur.pm * tstep; const char* cB = (const char*)Btbase + (size_t)cur.bt * tstep;
    PG8_STAGE(PG8_SB(0, 0), cB, voffB); PG8_STAGE(PG8_SB(0, 1), cB + hstep, voffB); PG8_STGA(PG8_SA(0, 0), cA, 0, gC); PG8_STGA(PG8_SA(0, 1), cA, 1, gC);
    if (wr == 1) PG8_BAR;
    PG8_WAIT_V(0); PG8_BAR;
    PG8_STAGE(PG8_SB(1, 0), cB + kstep, voffB); PG8_STGA(PG8_SA(1, 0), cA + kstep, 0, gC); PG8_STAGE(PG8_SB(1, 1), cB + hstep + kstep, voffB);
    PG8_WAIT_V(0); PG8_BAR;
    for (;;) {
        const bool has_next = S.next(ui + 1, nxt);
        const char* nA = GATHER ? (const char*)Abase : (has_next ? (const char*)Abase + (size_t)nxt.pm * tstep : cA); const char* nB = has_next ? (const char*)Btbase + (size_t)nxt.bt * tstep : cB;
        if constexpr (GATHER) {
            if (has_next) {
#pragma unroll
                for (int h = 0; h < 2; ++h)
#pragma unroll
                    for (int i = 0; i < 2; ++i) gN[h][i] = gtab[(ui + 1) * 256 + h * HALF + RA[i]] + (unsigned)CA2[i];
            } else {
#pragma unroll
                for (int h = 0; h < 2; ++h)
#pragma unroll
                    for (int i = 0; i < 2; ++i) gN[h][i] = gC[h][i];
            }
        }
        for (int t = 0; t < nt; t += 2) {
            const bool last = (t == nt - 2);
            const char* a1 = cA + (size_t)(t + 1) * kstep;
            const char* a2 = last ? nA : cA + (size_t)(t + 2) * kstep; const char* b2 = last ? nB : cB + (size_t)(t + 2) * kstep;
            const char* a3 = a2 + kstep; const char* b3 = b2 + kstep;
            unsigned g2[2][2];
            if constexpr (GATHER) {
#pragma unroll
                for (int h = 0; h < 2; ++h)
#pragma unroll
                    for (int i = 0; i < 2; ++i) g2[h][i] = last ? gN[h][i] : gC[h][i];
            }
            PG8_LDB(B0, 0, 0); PG8_LDB(B1, 0, 1); PG8_SCHED; PG8_LDA(At, 0, 0); PG8_WAIT_V(0); PG8_STGA(PG8_SA(1, 1), a1, 1, gC);
            PG8_WAIT_L(0); PG8_BAR; PG8_MMA(0, 0, At, B0); PG8_MMA(0, 1, At, B1); PG8_BAR; PG8_SCHED;
            PG8_LDA(At, 0, 1); PG8_WAIT_V(0); PG8_STAGE(PG8_SB(0, 0), b2, voffB); PG8_STAGE(PG8_SB(0, 1), b2 + hstep, voffB); PG8_STGA(PG8_SA(0, 0), a2, 0, g2);
            PG8_WAIT_L(0); PG8_BAR; PG8_MMA(1, 0, At, B0); PG8_MMA(1, 1, At, B1); PG8_BAR; PG8_SCHED;
            PG8_LDB(B0, 1, 0); PG8_LDB(B1, 1, 1); PG8_SCHED; PG8_LDA(At, 1, 0); PG8_WAIT_V(0); PG8_STGA(PG8_SA(0, 1), a2, 1, g2);
            PG8_WAIT_L(0); PG8_BAR; PG8_MMA(0, 0, At, B0); PG8_MMA(0, 1, At, B1); PG8_BAR; PG8_SCHED;
            PG8_LDA(At, 1, 1); PG8_WAIT_V(0); PG8_STAGE(PG8_SB(1, 0), b3, voffB); PG8_STAGE(PG8_SB(1, 1), b3 + hstep, voffB); PG8_STGA(PG8_SA(1, 0), a3, 0, g2);
            PG8_WAIT_L(0); PG8_BAR; PG8_MMA(1, 0, At, B0); PG8_MMA(1, 1, At, B1); PG8_BAR; PG8_SCHED;
        }
        if (wr == 0) PG8_BAR;
        E(acc, cur, ui, wr, wc, fr, fq);
        if (!has_next) break;
#pragma unroll
        for (int a = 0; a < 2; ++a)
#pragma unroll
            for (int b = 0; b < 2; ++b)
#pragma unroll
                for (int m = 0; m < 4; ++m)
#pragma unroll
                    for (int n = 0; n < 2; ++n) acc[a][b][m][n] = (f32x4){0.f, 0.f, 0.f, 0.f};
        cur = nxt; cA = nA; cB = nB; ++ui;
        if constexpr (GATHER) {
#pragma unroll
            for (int h = 0; h < 2; ++h)
#pragma unroll
                for (int i = 0; i < 2; ++i) gC[h][i] = gN[h][i];
        }
        if (wr == 1) PG8_BAR;
    }
    PG8_WAIT_V(0);
    PG8_BAR;
#undef PG8_SA
#undef PG8_SB
#undef PG8_STAGE
#undef PG8_STGA
#undef PG8_LDA
#undef PG8_LDB
#undef PG8_MMA
#undef PG8_WAIT_V
#undef PG8_WAIT_L
#undef PG8_BAR
#undef PG8_SCHED
}

typedef f32x4 Acc[2][2][4][2];
struct EpiRowScaleBf16 {
    static constexpr bool PERM = true;
    bf16_t* O; int ldc; const float* rs; int split_cols; size_t split_stride;
    __device__ __forceinline__ void operator()(const Acc& acc, const Unit& u, int, int wr, int wc, int fr, int fq) const {
        const int row0 = u.pm * BM + wr * 64 + fr; int colt = u.pn * BM; bf16_t* base = O;
        if (split_cols) { const int t = colt / split_cols; base += (size_t)t * split_stride; colt -= t * split_cols; }
        const int col0 = colt + wc * 32 + 8 * fq;
#pragma unroll
        for (int ai = 0; ai < 2; ++ai)
#pragma unroll
            for (int m = 0; m < 4; ++m) { const int row = row0 + ai * HALF + m * 16; const float s = ld_coh(rs + row); bf16_t* rowp = base + (size_t)row * ldc + col0;
#pragma unroll
                for (int bj = 0; bj < 2; ++bj) { const f32x4 v0 = acc[ai][bj][m][0] * s, v1 = acc[ai][bj][m][1] * s;
                    u32x4 w; w.x = cvt_pk_bf16(v0[0], v0[1]); w.y = cvt_pk_bf16(v0[2], v0[3]); w.z = cvt_pk_bf16(v1[0], v1[1]); w.w = cvt_pk_bf16(v1[2], v1[3]);
                    st16_wt(rowp + bj * HALF, w); } }
    }
};
struct EpiGlu {
    static constexpr bool PERM = false;
    const float* X; float* H;
    __device__ __forceinline__ void operator()(const Acc& acc, const Unit& u, int, int wr, int wc, int fr, int fq) const {
        const int row0 = u.pm * BM + wr * 64 + fr, col0 = u.pn * HALF + wc * 32 + 4 * fq;
#pragma unroll
        for (int ai = 0; ai < 2; ++ai)
#pragma unroll
            for (int m = 0; m < 4; ++m) { const size_t off = (size_t)(row0 + ai * HALF + m * 16) * DM + col0;
#pragma unroll
                for (int n = 0; n < 2; ++n) { const f32x4 a = acc[ai][0][m][n], b = acc[ai][1][m][n]; const f32x4 xv = *(const f32x4*)(X + off + n * 16);
                    f32x4 o; o[0] = xv[0] + a[0] * fast_sigmoid(b[0]); o[1] = xv[1] + a[1] * fast_sigmoid(b[1]); o[2] = xv[2] + a[2] * fast_sigmoid(b[2]); o[3] = xv[3] + a[3] * fast_sigmoid(b[3]);
                    st16_wt(H + off + n * 16, o); } }
    }
};
struct EpiGateUp {
    static constexpr bool PERM = true;
    bf16_t* Hm; const LAS float* tabR; const LAS float* tabW;
    __device__ __forceinline__ void operator()(const Acc& acc, const Unit& u, int ui, int wr, int wc, int fr, int fq) const {
        const int col0 = u.pn * HALF + wc * 32 + 8 * fq;
#pragma unroll
        for (int ai = 0; ai < 2; ++ai)
#pragma unroll
            for (int m = 0; m < 4; ++m) { const int rl = ai * HALF + wr * 64 + m * 16 + fr; const float r = tabR[ui * 256 + rl], w = tabW[ui * 256 + rl];
                float hv[8];
#pragma unroll
                for (int n = 0; n < 2; ++n)
#pragma unroll
                    for (int j = 0; j < 4; ++j) { const float g = acc[ai][0][m][n][j] * r, up = acc[ai][1][m][n][j] * r; hv[n * 4 + j] = g * fast_sigmoid(g) * up * w; }
                u32x4 o; o.x = cvt_pk_bf16(hv[0], hv[1]); o.y = cvt_pk_bf16(hv[2], hv[3]); o.z = cvt_pk_bf16(hv[4], hv[5]); o.w = cvt_pk_bf16(hv[6], hv[7]);
                st16_wt(Hm + (size_t)(u.pm * BM + rl) * FF + col0, o); }
    }
};
struct EpiDown {
    static constexpr bool PERM = true;
    bf16_t* Y; const LAS unsigned* tabD;
    __device__ __forceinline__ void operator()(const Acc& acc, const Unit& u, int ui, int wr, int wc, int fr, int fq) const {
        const int col0 = u.pn * BM + wc * 32 + 8 * fq;
#pragma unroll
        for (int ai = 0; ai < 2; ++ai)
#pragma unroll
            for (int m = 0; m < 4; ++m) { const int rl = ai * HALF + wr * 64 + m * 16 + fr; const unsigned d = tabD[ui * 256 + rl];
                if (d != 0xFFFFFFFFu) { bf16_t* rowp = Y + (size_t)d * DM + col0;
#pragma unroll
                    for (int bj = 0; bj < 2; ++bj) { const f32x4 v0 = acc[ai][bj][m][0], v1 = acc[ai][bj][m][1];
                        u32x4 w; w.x = cvt_pk_bf16(v0[0], v0[1]); w.y = cvt_pk_bf16(v0[2], v0[3]); w.z = cvt_pk_bf16(v1[0], v1[1]); w.w = cvt_pk_bf16(v1[2], v1[3]);
                        st16_wt(rowp + bj * HALF, w); } } }
    }
};
struct EpiResAdd {
    static constexpr bool PERM = false;
    float* H;
    __device__ __forceinline__ void operator()(const Acc& acc, const Unit& u, int, int wr, int wc, int fr, int fq) const {
        const int row0 = u.pm * BM + wr * 64 + fr, col0 = u.pn * BM + wc * 32 + 4 * fq;
#pragma unroll
        for (int ai = 0; ai < 2; ++ai)
#pragma unroll
            for (int m = 0; m < 4; ++m) { float* rowp = H + (size_t)(row0 + ai * HALF + m * 16) * DM + col0;
#pragma unroll
                for (int bj = 0; bj < 2; ++bj)
#pragma unroll
                    for (int n = 0; n < 2; ++n) { f32x4* p = (f32x4*)(rowp + bj * HALF + n * 16); const f32x4 t = *p + acc[ai][bj][m][n]; st16_wt(p, t); } }
    }
};
}

struct Args { const float* in[32]; float* out; unsigned char* ws; int ph_lo, ph_hi; int dbg_kind, dbg_pad; size_t dbg_off; };
typedef const __attribute__((address_space(4))) Args* KArgsPtr;
struct Frame {
    LAS unsigned char* lds; unsigned* ctl;
    int tid, lane, wave, vcu, G, bid;
    unsigned char* ws;
};
__device__ __forceinline__ KArgsPtr launder_args(KArgsPtr kp) { asm volatile("" : "+s"(kp)); return kp; }
__device__ __forceinline__ Frame make_frame(KArgsPtr a, LAS unsigned char* lds) {
    Frame F; { unsigned lb = (unsigned)(uintptr_t)lds; asm volatile("" : "+s"(lb)); F.lds = (LAS unsigned char*)(uintptr_t)lb; } F.tid = tid_opaque(); F.lane = F.tid & 63; F.wave = __builtin_amdgcn_readfirstlane(F.tid >> 6);
    F.G = grid_opaque(); F.bid = bid_opaque(); { const int bx = F.bid; F.vcu = (F.G % 8 == 0) ? (bx % 8) * (F.G / 8) + bx / 8 : bx; }
    F.ws = a->ws; F.ctl = (unsigned*)(F.ws + WS_CTL);
    return F;
}

__device__ __forceinline__ void conv_tile(const float* __restrict__ W, int N, int k0, int n0, const float* __restrict__ gain, int gmask, float gscale,
                                          bf16_t* __restrict__ dst, int ldk, int drow0, LAS unsigned* scr, int lane) {
    const int kk = lane >> 4, nq = lane & 15;
    f32x4 v[16];
#pragma unroll
    for (int i = 0; i < 16; ++i) v[i] = *(const f32x4*)(W + (size_t)(k0 + 2 * kk + (i & 1) + 8 * (i >> 1)) * N + n0 + 4 * nq);
#pragma unroll
    for (int ip = 0; ip < 8; ++ip) {
        const int k = k0 + 2 * kk + 8 * ip;
        const float g0 = gain ? gain[k & gmask] * gscale : 1.0f, g1 = gain ? gain[(k + 1) & gmask] * gscale : 1.0f;
#pragma unroll
        for (int j = 0; j < 4; ++j) { const int n = 4 * nq + j; scr[n * 32 + ((kk + 4 * ip) ^ (nq << 1))] = cvt_pk_bf16(v[2 * ip][j] * g0, v[2 * ip + 1][j] * g1); }
    }
    LDS_WAIT();
#pragma unroll
    for (int jj = 0; jj < 8; ++jj) {
        const int n = (lane >> 3) + 8 * jj, c = lane & 7;
        u32x4 w = *(const LAS u32x4*)(scr + n * 32 + 4 * (c ^ jj));
        if ((n >> 2) & 1) w = (u32x4){w.z, w.w, w.x, w.y};
        st16_wt(dst + (size_t)(drow0 + n) * ldk + k0 + 8 * c, w);
    }
    LDS_WAIT();
}
__device__ __forceinline__ int ileave(int n0) { return (n0 >> 7) * 256 + (n0 & 127); }

__device__ __forceinline__ void p0_prologue(Frame& F, KArgsPtr a) {
    LAS unsigned* scr = (LAS unsigned*)(F.lds + F.wave * 8192);
    const int gw = F.vcu * NWAVES + F.wave, NGW = F.G * NWAVES, lane = F.lane;
    unsigned char* ws = F.ws;
    constexpr int T_WIN = 64 * 32, T_GL = 32 * 64, T_SQ = 64 * 64, T_EXP = 3 * 1024;
    constexpr int O_GLA = T_WIN, O_GLB = O_GLA + T_GL, O_Q = O_GLB + T_GL, O_K = O_Q + T_SQ, O_V = O_K + T_SQ, O_O = O_V + T_SQ, O_MOE = O_O + T_SQ, NT_ALL = O_MOE + 32 * T_EXP;
    for (int it = gw; it < NT_ALL; it += NGW) {
        if (it < O_GLA) { const int r = it, kb = r / 32, nb = r % 32;
            conv_tile(a->in[1], SW, kb * 64, nb * 64, a->in[29], -1, 1.f, (bf16_t*)(ws + WS_WIN), DM, nb * 64, scr, lane); }
        else if (it < O_Q) { const int half = it >= O_GLB; const int r = it - (half ? O_GLB : O_GLA), kb = r / 64, nb = r % 64;
            conv_tile(half ? a->in[11] : a->in[10], DM, kb * 64, nb * 64, nullptr, -1, 1.f, (bf16_t*)(ws + WS_GLU), SW, ileave(nb * 64) + half * 128, scr, lane); }
        else if (it < O_O) { const int which = (it - O_Q) / T_SQ; const int r = (it - O_Q) % T_SQ, kb = r / 64, nb = r % 64;
            const float* W = which == 0 ? a->in[15] : (which == 1 ? a->in[13] : a->in[14]); const float* g = which == 0 ? a->in[29] + DM : a->in[12];
            conv_tile(W, AW, kb * 64, nb * 64, g, -1, 1.f, (bf16_t*)(ws + WS_QKV), DM, which * AW + nb * 64, scr, lane); }
        else if (it < O_MOE) { const int r = it - O_O, kb = r / 64, nb = r % 64;
            conv_tile(a->in[21], DM, kb * 64, nb * 64, a->in[20], 255, 1.0f - LAMBDA_INIT1, (bf16_t*)(ws + WS_WO), AW, nb * 64, scr, lane); }
        else { const int r0 = it - O_MOE, le = r0 / T_EXP, r1 = r0 % T_EXP, which = r1 / 1024, r = r1 % 1024, li = le / NE;
            if (which < 2) { const int kb = r / 16, nb = r % 16;
                conv_tile((which ? a->in[27] : a->in[26]) + (size_t)le * DM * FF, FF, kb * 64, nb * 64, a->in[30] + li * DM, -1, 1.f,
                          (bf16_t*)(ws + WS_GU) + (size_t)le * 2048 * DM, DM, ileave(nb * 64) + which * 128, scr, lane); }
            else { const int kb = r / 64, nb = r % 64;
                conv_tile(a->in[28] + (size_t)le * FF * DM, DM, kb * 64, nb * 64, nullptr, -1, 1.f, (bf16_t*)(ws + WS_DN) + (size_t)le * DM * FF, FF, nb * 64, scr, lane); } }
    }
    { float* WrT = (float*)(ws + WS_WRT);
      for (int i = (F.vcu * NWAVES + F.wave) * 64 + lane; i < 2 * 32 * DM; i += NGW * 64) { const int li = i / (32 * DM), c = (i / DM) % 32, k = i % DM; const float g = a->in[30][li * DM + k];
          float v = 0.f; if (c < 4) v = a->in[22][((size_t)li * DM + k) * 4 + c] * g; else if (c < 20) v = a->in[24][((size_t)li * DM + k) * 16 + (c - 4)] * g;
          st4_wt(WrT + i, __builtin_bit_cast(unsigned, v)); } }
    { const float* x = a->in[0]; bf16_t* xb = (bf16_t*)(ws + WS_XB); float* rstd = (float*)(ws + WS_RSTD);
      for (int m = gw; m < T; m += NGW) { const f32x4* xr = (const f32x4*)(x + (size_t)m * DM) + lane; u32x2* o8 = (u32x2*)(xb + (size_t)m * DM) + lane; float s = 0.f;
#pragma unroll
          for (int j = 0; j < 16; ++j) { const f32x4 v = xr[64 * j]; s += (v.x * v.x + v.y * v.y) + (v.z * v.z + v.w * v.w); st8_wt(o8 + 64 * j, (u32x2){cvt_pk_bf16(v.x, v.y), cvt_pk_bf16(v.z, v.w)}); }
          s = wave_sum(s); if (lane == 0) st_coh(rstd + m, 1.0f / sqrtf(s * (1.0f / DM) + EPS)); } }
}

template <bool COMBINE, bool ROUTER>
__device__ __forceinline__ void rn_phase(Frame& F, float* H, const bf16_t* Y, bf16_t* hb, float* rstd, const float* WrT, const float* bgroup, const float* brouter,
                                         unsigned* cnt, int* list_tok, float* list_w) {
    LAS float* pss = (LAS float*)(F.lds);
    LAS float* plg = (LAS float*)(F.lds + 1024);
    const int lane = F.lane, r = lane & 15, kq = lane >> 4, wave = F.wave;
    for (int task = F.vcu; task < T / 16; task += F.G) {
        const int row = task * 16 + r; const size_t rb = (size_t)row * DM + wave * 512 + 4 * kq;
        f32x4 acc0 = {0.f, 0.f, 0.f, 0.f}, acc1 = {0.f, 0.f, 0.f, 0.f}; float ss = 0.f;
        const float* w0p = WrT + (size_t)r * DM + wave * 512 + 4 * kq; const float* w1p = w0p + (size_t)16 * DM;
#pragma unroll 8
        for (int s = 0; s < 32; ++s) {
            f32x4 v = *(const f32x4*)(H + rb + 16 * s);
            if constexpr (COMBINE) { const u32x2 ya = *(const u32x2*)(Y + rb + 16 * s), yb2 = *(const u32x2*)(Y + (size_t)T * DM + rb + 16 * s);
                v.x += bf2f(ya.x & 0xffffu) + bf2f(yb2.x & 0xffffu); v.y += bf2f(ya.x >> 16) + bf2f(yb2.x >> 16); v.z += bf2f(ya.y & 0xffffu) + bf2f(yb2.y & 0xffffu); v.w += bf2f(ya.y >> 16) + bf2f(yb2.y >> 16);
                st16_wt(H + rb + 16 * s, v); }
            ss += (v.x * v.x + v.y * v.y) + (v.z * v.z + v.w * v.w);
            st8_wt(hb + rb + 16 * s, (u32x2){cvt_pk_bf16(v.x, v.y), cvt_pk_bf16(v.z, v.w)});
            if constexpr (ROUTER) { const f32x4 w0 = *(const f32x4*)(w0p + 16 * s), w1 = *(const f32x4*)(w1p + 16 * s);
#pragma unroll
                for (int j = 0; j < 4; ++j) { acc0 = __builtin_amdgcn_mfma_f32_16x16x4f32(v[j], w0[j], acc0, 0, 0, 0); acc1 = __builtin_amdgcn_mfma_f32_16x16x4f32(v[j], w1[j], acc1, 0, 0, 0); } }
        }
        ss += __shfl_xor(ss, 16); ss += __shfl_xor(ss, 32);
        if (kq == 0) pss[wave * 16 + r] = ss;
        if constexpr (ROUTER) {
#pragma unroll
            for (int q = 0; q < 4; ++q) { plg[(wave * 16 + 4 * kq + q) * 32 + r] = acc0[q]; plg[(wave * 16 + 4 * kq + q) * 32 + 16 + r] = acc1[q]; } }
        __syncthreads();
        if (F.tid < 16) { const int t = F.tid, tok = task * 16 + t; float s = 0.f;
#pragma unroll
            for (int w = 0; w < 8; ++w) s += pss[w * 16 + t];
            const float rs = 1.0f / sqrtf(s * (1.0f / DM) + EPS); st_coh(rstd + tok, rs);
            if constexpr (ROUTER) {
                float lg[4];
#pragma unroll
                for (int c = 0; c < 4; ++c) { float q = 0.f;
#pragma unroll
                    for (int w = 0; w < 8; ++w) q += plg[(w * 16 + t) * 32 + c];
                    lg[c] = q * rs + bgroup[c]; }
                int gi = 0; float gm = lg[0];
#pragma unroll
                for (int c = 1; c < 4; ++c) if (lg[c] > gm) { gm = lg[c]; gi = c; }
                float den = 0.f;
#pragma unroll
                for (int c = 0; c < 4; ++c) den += expf(lg[c] - gm);
                const float gval = 1.0f / den;
                float sv[4];
#pragma unroll
                for (int j = 0; j < 4; ++j) { float q = 0.f;
#pragma unroll
                    for (int w = 0; w < 8; ++w) q += plg[(w * 16 + t) * 32 + 4 + 4 * gi + j];
                    sv[j] = q * rs + brouter[4 * gi + j]; }
                int i1 = 0; float v1 = sv[0];
#pragma unroll
                for (int j = 1; j < 4; ++j) if (sv[j] > v1) { v1 = sv[j]; i1 = j; }
                int i2 = -1; float v2 = -3.0e38f;
#pragma unroll
                for (int j = 0; j < 4; ++j) if (j != i1 && sv[j] > v2) { v2 = sv[j]; i2 = j; }
                const float w1 = 1.0f / (1.0f + expf(v2 - v1)), w2 = 1.0f - w1;
                const int e1 = 4 * gi + i1, e2 = 4 * gi + i2;
#ifdef DBG_ROUTE
                { float* dbg = (float*)(F.ws + WS_OB) + (size_t)tok * 4096; for (int q = 0; q < 4096; q += 4) { dbg[q] = (float)e1; dbg[q + 1] = (float)e2; dbg[q + 2] = w1 * gval; dbg[q + 3] = rs; } }
#endif
                const unsigned p1 = __hip_atomic_fetch_add(cnt + e1 * 64, 1u, __ATOMIC_RELAXED, __HIP_MEMORY_SCOPE_AGENT);
                const unsigned p2 = __hip_atomic_fetch_add(cnt + e2 * 64, 1u, __ATOMIC_RELAXED, __HIP_MEMORY_SCOPE_AGENT);
                if (p1 < (unsigned)LISTCAP) { st_coh(list_tok + e1 * LISTCAP + p1, tok * 2); st_coh(list_w + e1 * LISTCAP + p1, w1 * gval); }
                if (p2 < (unsigned)LISTCAP) { st_coh(list_tok + e2 * LISTCAP + p2, tok * 2 + 1); st_coh(list_w + e2 * LISTCAP + p2, w2 * gval); }
            }
        }
        __syncthreads();
    }
}

template <bool DOWN>
__device__ __forceinline__ int build_group(Frame& F, const unsigned* cnt, const int* list_tok, const float* list_w, const float* rstd, int nN, int K2  ) {
    LAS int* ti = (LAS int*)(F.lds + TAB_OFF);
    LAS unsigned* tabA = (LAS unsigned*)(F.lds + TAB_OFF + 256);
    LAS float* tabR = (LAS float*)(F.lds + TAB_OFF + 256 + 8 * 1024);
    LAS float* tabW = (LAS float*)(F.lds + TAB_OFF + 256 + 16 * 1024);
    if (F.tid == 0) {
        int ts = 0;
        for (int e = 0; e < NE; ++e) { ti[8 + e] = ts; const unsigned c = __hip_atomic_load(cnt + e * 64, __ATOMIC_RELAXED, __HIP_MEMORY_SCOPE_AGENT); ts += (int)((c > (unsigned)LISTCAP ? (unsigned)LISTCAP : c) + 255u) >> 8; }
        ti[8 + NE] = ts;
        int n = 0;
        for (int i = 0; n < 8; ++i) { const long L = (long)i * F.G + F.bid; if (L >= (long)ts * nN) break; int pm, pn; pg8::tile_of((int)L, ts, nN, pm, pn);
            int e = 0; while (e < NE - 1 && ti[8 + e + 1] <= pm) ++e;
            ti[32 + 3 * n] = pm; ti[32 + 3 * n + 1] = pn; ti[32 + 3 * n + 2] = e * nN + pn; ++n; }
        ti[0] = n;
    }
    __syncthreads();
    const int n = ti[0];
    for (int i = 0; i < n; ++i) {
        if (F.tid < 256) { const int rr = F.tid, pm = ti[32 + 3 * i], e = ti[32 + 3 * i + 2] / nN, idx = (pm - ti[8 + e]) * 256 + rr;
            unsigned c = __hip_atomic_load(cnt + e * 64, __ATOMIC_RELAXED, __HIP_MEMORY_SCOPE_AGENT); if (c > (unsigned)LISTCAP) c = LISTCAP;
            const bool valid = (unsigned)idx < c;
            int tk = 0; float w = 0.f; if (valid) { tk = ld_coh(list_tok + e * LISTCAP + idx); w = ld_coh(list_w + e * LISTCAP + idx); }
            if constexpr (DOWN) { tabA[i * 256 + rr] = valid ? (unsigned)((tk & 1) * T + (tk >> 1)) : 0xFFFFFFFFu; }
            else { tabA[i * 256 + rr] = (unsigned)(tk >> 1) * (unsigned)K2; tabR[i * 256 + rr] = valid ? ld_coh(rstd + (tk >> 1)) : 0.f; tabW[i * 256 + rr] = w; } }
    }
    __syncthreads();
    return n;
}

__device__ __forceinline__ float gelu_tanh(float y) { const float z = 1.5957691216f * (y + 0.044715f * y * y * y); return y * fast_sigmoid(z); }
struct Cx { float re, im; };
__device__ __forceinline__ Cx cmul(Cx a, Cx b) { return {a.re * b.re - a.im * b.im, a.re * b.im + a.im * b.re}; }
__device__ __forceinline__ Cx cfma(Cx a, Cx b, Cx c) { return {fmaf(a.re, b.re, fmaf(-a.im, b.im, c.re)), fmaf(a.re, b.im, fmaf(a.im, b.re, c.im))}; }
template <int PASS>
__device__ __forceinline__ void scan_task(KArgsPtr a, unsigned char* ws, LAS unsigned char* wlds, int b, int g, int seg, int lane) {
    const int c = lane & 31, hi = lane >> 5; int chkflag = 0; (void)chkflag;
    const bf16_t* ub = (const bf16_t*)(ws + WS_UB); bf16_t* yb = (bf16_t*)(ws + WS_YB); float* ends = (float*)(ws + WS_ENDS);
    const float dt = expf(a->in[4][g]);
    Cx lam[2], lam16[2]; bf16x8 Bre[2], Bim[2];
#pragma unroll
    for (int s = 0; s < 2; ++s) { const int p = c + 32 * s; const float are = a->in[2][g * SP + p], aim = a->in[3][g * SP + p];
        const float mag = expf(are * dt), th = aim * dt; const float lr = mag * __cosf(th), li = mag * __sinf(th);
        lam[s] = {lr, li};
        const float den = are * are + aim * aim, nr = lr - 1.0f; const float qre = (nr * are + li * aim) / den, qim = (li * are - nr * aim) / den;
        const float* brp = a->in[5] + ((size_t)(g * SP + p)) * SJ + 8 * hi; const float* bip = a->in[6] + ((size_t)(g * SP + p)) * SJ + 8 * hi;
        const f32x4 br0 = *(const f32x4*)brp, br1 = *(const f32x4*)(brp + 4), bi0 = *(const f32x4*)bip, bi1 = *(const f32x4*)(bip + 4);
        float vr[8], vi[8];
#pragma unroll
        for (int j = 0; j < 4; ++j) { vr[j] = qre * br0[j] - qim * bi0[j]; vi[j] = qre * bi0[j] + qim * br0[j]; vr[4 + j] = qre * br1[j] - qim * bi1[j]; vi[4 + j] = qre * bi1[j] + qim * br1[j]; }
        u32x4 wr_ = {cvt_pk_bf16(vr[0], vr[1]), cvt_pk_bf16(vr[2], vr[3]), cvt_pk_bf16(vr[4], vr[5]), cvt_pk_bf16(vr[6], vr[7])};
        u32x4 wi_ = {cvt_pk_bf16(vi[0], vi[1]), cvt_pk_bf16(vi[2], vi[3]), cvt_pk_bf16(vi[4], vi[5]), cvt_pk_bf16(vi[6], vi[7])};
        Bre[s] = __builtin_bit_cast(bf16x8, wr_); Bim[s] = __builtin_bit_cast(bf16x8, wi_);
        Cx l2 = cmul(lam[s], lam[s]), l4 = cmul(l2, l2), l8 = cmul(l4, l4); lam16[s] = cmul(l8, l8); }
    Cx carry[2] = {{0.f, 0.f}, {0.f, 0.f}};
    bf16x8 Cf[4]; float dsk = 0.f;
    if constexpr (PASS == 2) {
        Cx lamL[2];
#pragma unroll
        for (int s = 0; s < 2; ++s) { Cx t = lam16[s]; for (int q = 16; q < LSEG; q <<= 1) t = cmul(t, t); lamL[s] = t; }
        for (int sp = 0; sp < seg; ++sp) {
#pragma unroll
            for (int s = 0; s < 2; ++s) { const float* ep = ends + ((size_t)((b * NG + g) * NSEG + sp)) * 128 + 2 * (c + 32 * s); carry[s] = cfma(lamL[s], carry[s], Cx{ld_coh(ep), ld_coh(ep + 1)}); } }
#ifdef DBG_SELFCHK2
        { Cx c2[2] = {{0.f, 0.f}, {0.f, 0.f}};
          for (int sp = 0; sp < seg; ++sp) {
#pragma unroll
            for (int s = 0; s < 2; ++s) { const float* ep = ends + ((size_t)((b * NG + g) * NSEG + sp)) * 128 + 2 * (c + 32 * s); c2[s] = cfma(lamL[s], c2[s], Cx{ld_coh(ep), ld_coh(ep + 1)}); } }
          _Pragma("unroll") for (int s = 0; s < 2; ++s) if (__builtin_bit_cast(unsigned, c2[s].re) != __builtin_bit_cast(unsigned, carry[s].re) || __builtin_bit_cast(unsigned, c2[s].im) != __builtin_bit_cast(unsigned, carry[s].im)) chkflag |= 2; }
#endif
        const int ca = lane & 15, kq = lane >> 4;
#pragma unroll
        for (int ks = 0; ks < 4; ++ks) { const f32x4 cr = *(const f32x4*)(a->in[7] + ((size_t)(g * SJ + ca)) * SP + 16 * ks + 4 * kq), ci = *(const f32x4*)(a->in[8] + ((size_t)(g * SJ + ca)) * SP + 16 * ks + 4 * kq);
            u32x4 w = {cvt_pk_bf16(cr[0], -ci[0]), cvt_pk_bf16(cr[1], -ci[1]), cvt_pk_bf16(cr[2], -ci[2]), cvt_pk_bf16(cr[3], -ci[3])}; Cf[ks] = __builtin_bit_cast(bf16x8, w); }
        dsk = a->in[9][g * SJ + ca];
    }
    const int tl = 16 * ((c >> 2) & 1) + (c & 3) + 4 * (c >> 3);
    LAS unsigned* Xs = (LAS unsigned*)wlds;
    for (int ch = 0; ch < LSEG / 32; ++ch) {
        const int t0 = b * SEQ + seg * LSEG + ch * 32;
        const bf16x8 af = *(const bf16x8*)(ub + (size_t)(t0 + tl) * SW + g * SJ + 8 * hi);
        f32x16 X[2][2];
#pragma unroll
        for (int s = 0; s < 2; ++s) { const f32x16 z = {};
            X[s][0] = __builtin_amdgcn_mfma_f32_32x32x16_bf16(af, Bre[s], z, 0, 0, 0); X[s][1] = __builtin_amdgcn_mfma_f32_32x32x16_bf16(af, Bim[s], z, 0, 0, 0); }
#pragma unroll
        for (int s = 0; s < 2; ++s) {
            Cx x = {0.f, 0.f};
#pragma unroll
            for (int r = 0; r < 16; ++r) { x = cfma(lam[s], x, Cx{X[s][0][r], X[s][1][r]}); X[s][0][r] = x.re; X[s][1][r] = x.im; }
            const Cx eo = {__shfl_xor(x.re, 32), __shfl_xor(x.im, 32)};
            if constexpr (PASS == 1) { const Cx e0 = hi ? eo : x, e1 = hi ? x : eo; carry[s] = cfma(lam16[s], cfma(lam16[s], carry[s], e0), e1); }
            else {
                const Cx cin1 = cfma(lam16[s], carry[s], eo); Cx w = hi ? cin1 : carry[s];
#pragma unroll
                for (int r = 0; r < 16; ++r) { w = cmul(lam[s], w); X[s][0][r] += w.re; X[s][1][r] += w.im; }
                const Cx fin = {X[s][0][15], X[s][1][15]}; const Cx fo = {__shfl_xor(fin.re, 32), __shfl_xor(fin.im, 32)};
                carry[s] = hi ? fin : fo;
#pragma unroll
                for (int r = 0; r < 16; ++r) Xs[(16 * hi + r) * 68 + c + 32 * s] = cvt_pk_bf16(X[s][0][r], X[s][1][r]);
            }
        }
        if constexpr (PASS == 2) {
            LDS_WAIT();
            const int ca = lane & 15, kq = lane >> 4;
#pragma unroll
            for (int rb = 0; rb < 2; ++rb) { f32x4 acc = {0.f, 0.f, 0.f, 0.f}; asm volatile("" : "+v"(acc));
#pragma unroll
                for (int ks = 0; ks < 4; ++ks) { const bf16x8 xf = *(const LAS bf16x8*)(Xs + (16 * rb + ca) * 68 + 16 * ks + 4 * kq); acc = __builtin_amdgcn_mfma_f32_16x16x32_bf16(xf, Cf[ks], acc, 0, 0, 0); }
#ifdef DBG_SELFCHK
                { f32x4 acc2 = {0.f, 0.f, 0.f, 0.f}; asm volatile("" : "+v"(acc2)); LDS_WAIT();
#pragma unroll
                  for (int ks = 0; ks < 4; ++ks) { const bf16x8 xf = *(const LAS bf16x8*)(Xs + (16 * rb + ca) * 68 + 16 * ks + 4 * kq); acc2 = __builtin_amdgcn_mfma_f32_16x16x32_bf16(xf, Cf[ks], acc2, 0, 0, 0); }
                  if (__builtin_bit_cast(unsigned, acc[0]) != __builtin_bit_cast(unsigned, acc2[0]) || __builtin_bit_cast(unsigned, acc[1]) != __builtin_bit_cast(unsigned, acc2[1]) ||
                      __builtin_bit_cast(unsigned, acc[2]) != __builtin_bit_cast(unsigned, acc2[2]) || __builtin_bit_cast(unsigned, acc[3]) != __builtin_bit_cast(unsigned, acc2[3])) chkflag |= 1; }
#endif
#pragma unroll
                for (int q = 0; q < 4; ++q) { const size_t o = (size_t)(t0 + 16 * rb + 4 * kq + q) * SW + g * SJ + ca; const float y = acc[q] + dsk * bf2f(ub[o]); st2_wt(yb + o, f2bf(gelu_tanh(y))); } }
            LDS_WAIT();
        }
    }
#if defined(DBG_SELFCHK) || defined(DBG_SELFCHK2) || defined(DBG_SELFCHK3)
    if constexpr (PASS == 2) { const int any = __any(chkflag != 0); float* dbg = (float*)(ws + WS_OC); if (lane == 0) dbg[(b * NG + g) * NSEG + seg] = any ? 1000.f : 0.f; }
#endif
    if constexpr (PASS == 1) { if (hi == 0) {
#pragma unroll
        for (int s = 0; s < 2; ++s) st8_wt(ends + ((size_t)((b * NG + g) * NSEG + seg)) * 128 + 2 * (c + 32 * s), (u32x2){__builtin_bit_cast(unsigned, carry[s].re), __builtin_bit_cast(unsigned, carry[s].im)}); } }
}
template <int PASS>
__device__ __forceinline__ void scan_phase(Frame& F, KArgsPtr a) {
    const int gw = F.vcu * NWAVES + F.wave, NGW = F.G * NWAVES;
    for (int task = gw; task < BATCH * NG * NSEG; task += NGW) { const int seg = task % NSEG, g = (task / NSEG) % NG, b = task / (NSEG * NG);
        if (PASS == 1 && seg == NSEG - 1) continue;
        scan_task<PASS>(a, F.ws, F.lds + F.wave * 9216, b, g, seg, F.lane); }
}

namespace att {
constexpr int D = 128, PITCH = 4096;
constexpr float SCALE = 0.08838834764831845f;
constexpr float THR = 8.f;
constexpr int NW = 8, QBLK = 32, KVBLK = 64, QB = NW * QBLK;
constexpr int SHM_V = KVBLK * D * 2, SHM_K = KVBLK * D * 2;
constexpr int ATT_LDS = 2 * SHM_V + 2 * SHM_K + NW * 64 * 4;
#define KSWZ(row, colB) ((row) * 256 + ((colB) ^ (((row) & 7) << 4)))
#define SBAR() __builtin_amdgcn_sched_barrier(0)
__device__ __forceinline__ int v_st(int k, int c) { const int kk = (k & ~0xC) | ((k & 4) << 1) | ((k & 8) >> 1); return ((kk >> 3) * 4 + (c >> 5)) * 512 + ((kk & 7) * 32 + (c & 31)) * 2; }
__device__ __forceinline__ int v_rd_base(int lane) { return ((lane & 3) << 3) | (((lane >> 2) & 3) << 6) | (((lane >> 4) & 1) << 5) | (((lane >> 5) & 1) << 8); }
constexpr int v_rd_off(int d0, int ks, int half) { return d0 * 512 + ks * 4096 + half * 2048; }
__device__ __forceinline__ int crow(int r, int hi) { return (r & 3) + 8 * (r >> 2) + 4 * hi; }
__device__ __forceinline__ unsigned cvtpk(float lo, float hi) { unsigned r; asm volatile("v_cvt_pk_bf16_f32 %0, %1, %2" : "=v"(r) : "v"(lo), "v"(hi)); return r; }
__device__ __forceinline__ bf16x8 load8(const bf16_t* p) { return *reinterpret_cast<const bf16x8*>(p); }
__device__ __forceinline__ void mask_tile(f32x16& p0, f32x16& p1, int dq, unsigned W) {
    const float NEG = -__builtin_inff();
#pragma unroll
    for (int r = 0; r < 16; ++r) { const int c = (r & 3) + 8 * (r >> 2);
        if ((unsigned)(dq - c) >= W) p0[r] = NEG;
        if ((unsigned)(dq - c - 32) >= W) p1[r] = NEG; }
}
__device__ __forceinline__ void partialSM(f32x16& p0, f32x16& p1, float& m_reg, float& mn, float& alpha) {
    float pmax = p0[0]; for (int r = 1; r < 16; ++r) pmax = fmaxf(pmax, p0[r]); for (int r = 0; r < 16; ++r) pmax = fmaxf(pmax, p1[r]);
    { auto rr = __builtin_amdgcn_permlane32_swap(__float_as_uint(pmax), __float_as_uint(pmax), false, false);
      pmax = fmaxf(__uint_as_float(rr[0]), __uint_as_float(rr[1])); }
    constexpr float C2 = 1.4426950408889634f * SCALE;
    if (__builtin_expect(__all((pmax - m_reg) * SCALE <= THR), 1)) { mn = m_reg; alpha = 1.f; }
    else { mn = fmaxf(m_reg, pmax); alpha = __builtin_amdgcn_exp2f((m_reg - mn) * C2); m_reg = mn; }
    const float mnL = -mn * C2;
    for (int r = 0; r < 16; ++r) p0[r] = fmaf(p0[r], C2, mnL); for (int r = 0; r < 16; ++r) p1[r] = fmaf(p1[r], C2, mnL);
    for (int r = 0; r < 16; ++r) p0[r] = __builtin_amdgcn_exp2f(p0[r]);
}
__device__ __forceinline__ void finishSM(f32x16& p0, f32x16& p1, float alpha, float& l_reg, bf16x8& pa0, bf16x8& pa1, bf16x8& pa2, bf16x8& pa3) {
    for (int r = 0; r < 16; ++r) p1[r] = __builtin_amdgcn_exp2f(p1[r]);
    float ps = 0; for (int r = 0; r < 16; ++r) ps += p0[r]; for (int r = 0; r < 16; ++r) ps += p1[r];
    { auto rr = __builtin_amdgcn_permlane32_swap(__float_as_uint(ps), __float_as_uint(ps), false, false);
      ps = __uint_as_float(rr[0]) + __uint_as_float(rr[1]); }
    l_reg = l_reg * alpha + ps;
#define PK4(P, B_, OUT) do { unsigned a0 = cvtpk(P[B_+0], P[B_+1]), a1 = cvtpk(P[B_+2], P[B_+3]);                          \
        unsigned b0 = cvtpk(P[B_+4], P[B_+5]), b1 = cvtpk(P[B_+6], P[B_+7]);                                             \
        auto r0 = __builtin_amdgcn_permlane32_swap(a0, b0, false, false); auto r1 = __builtin_amdgcn_permlane32_swap(a1, b1, false, false); \
        u32x4 w = {r0[0], r1[0], r0[1], r1[1]}; OUT = *reinterpret_cast<bf16x8*>(&w); } while (0)
    PK4(p0, 0, pa0); PK4(p0, 8, pa1); PK4(p1, 0, pa2); PK4(p1, 8, pa3);
#undef PK4
}
template <int KB>
__device__ __forceinline__ void qkt(f32x16& p0, f32x16& p1, const char* K_lds, int r32, int hi, const bf16x8* qr, float sl, float tb) {
    { const float sl8 = 8.0f * sl, sl32 = 32.0f * sl;
#pragma unroll
      for (int r = 0; r < 16; ++r) { p0[r] = (r == 0) ? tb : ((r & 3) ? p0[r - 1] + sl : p0[r - 4] + sl8); }
#pragma unroll
      for (int r = 0; r < 16; ++r) p1[r] = p0[r] + sl32; }
    const char* kb[4];
#pragma unroll
    for (int dd = 0; dd < 4; ++dd) kb[dd] = K_lds + KB * SHM_K + KSWZ(r32, (dd * 16 + hi * 8) * 2);
#pragma unroll
    for (int d0 = 0; d0 < 8; ++d0) { const char* a = kb[d0 & 3] + (d0 >> 2) * 128;
        bf16x8 b0 = *reinterpret_cast<const bf16x8*>(a);
        bf16x8 b1 = *reinterpret_cast<const bf16x8*>(a + 32 * 256);
        p0 = __builtin_amdgcn_mfma_f32_32x32x16_bf16(b0, qr[d0], p0, 0, 0, 0);
        p1 = __builtin_amdgcn_mfma_f32_32x32x16_bf16(b1, qr[d0], p1, 0, 0, 0); }
}
template <int VB>
__device__ __forceinline__ void pv_tile(f32x16* o, int vb0, bf16x8 pa0, bf16x8 pa1, bf16x8 pa2, bf16x8 pa3) {
#define TRRD(dst, off) asm volatile("ds_read_b64_tr_b16 %0, %1 offset:%2" : "=&v"(dst) : "v"(vb0), "i"(off) : "memory")
#define PV_D0(d0) do { s16x4 l0, l1, l2, l3, h0, h1, h2, h3; constexpr int b_ = VB * SHM_V + v_rd_off(d0, 0, 0);  \
        TRRD(l0, b_); TRRD(h0, b_ + 2048); TRRD(l1, b_ + 4096); TRRD(h1, b_ + 6144); TRRD(l2, b_ + 8192); TRRD(h2, b_ + 10240); TRRD(l3, b_ + 12288); TRRD(h3, b_ + 14336); \
        asm volatile("s_waitcnt lgkmcnt(0)" ::: "memory"); SBAR();   \
        o[d0] = __builtin_amdgcn_mfma_f32_32x32x16_bf16(pa0, (bf16x8){l0[0], l0[1], l0[2], l0[3], h0[0], h0[1], h0[2], h0[3]}, o[d0], 0, 0, 0);   \
        o[d0] = __builtin_amdgcn_mfma_f32_32x32x16_bf16(pa1, (bf16x8){l1[0], l1[1], l1[2], l1[3], h1[0], h1[1], h1[2], h1[3]}, o[d0], 0, 0, 0);   \
        o[d0] = __builtin_amdgcn_mfma_f32_32x32x16_bf16(pa2, (bf16x8){l2[0], l2[1], l2[2], l2[3], h2[0], h2[1], h2[2], h2[3]}, o[d0], 0, 0, 0);   \
        o[d0] = __builtin_amdgcn_mfma_f32_32x32x16_bf16(pa3, (bf16x8){l3[0], l3[1], l3[2], l3[3], h3[0], h3[1], h3[2], h3[3]}, o[d0], 0, 0, 0); } while (0)
    PV_D0(0); PV_D0(1); PV_D0(2); PV_D0(3);
#undef PV_D0
#undef TRRD
}
struct BlockRef { const bf16_t* Q; const bf16_t* K; const bf16_t* V; bf16_t* O; int P0; float sl; };
struct Seam { bf16x8 qr[8]; bf16x8 st_v0, st_v1, st_k0, st_k1; };
#define ROW(p, k0, rr) ((p) + (size_t)((k0) + (rr)) * PITCH + sc)
#define VMW() asm volatile("s_waitcnt vmcnt(0)" ::: "memory")
#define VMWN(n) asm volatile("s_waitcnt vmcnt(%0)" :: "i"(n) : "memory")
#define SLOAD_H(Kp, Vp, k0) do { S.st_v0 = load8(ROW(Vp, k0, sr)); S.st_v1 = load8(ROW(Vp, k0, 32 + sr));              \
                         S.st_k0 = load8(ROW(Kp, k0, sr)); S.st_k1 = load8(ROW(Kp, k0, 32 + sr)); } while (0)
#define SWRITE_HK(bf) do { *(bf16x8*)(K_lds + (bf) * SHM_K + kws) = S.st_k0; *(bf16x8*)(K_lds + (bf) * SHM_K + kws + 32 * 256) = S.st_k1; } while (0)
#define SWRITE_HV(bf) do { *(bf16x8*)(V_lds + (bf) * SHM_V + vst0) = S.st_v0; *(bf16x8*)(V_lds + (bf) * SHM_V + vst1) = S.st_v1; } while (0)
#define SWRITE_H(bf) do { SWRITE_HV(bf); SWRITE_HK(bf); } while (0)
__device__ __forceinline__ void causal_prime(const BlockRef& cur, char* lds, Seam& S) {
    const int tid = tid_opaque(), wid = __builtin_amdgcn_readfirstlane(tid >> 6), lane = tid & 63, r32 = lane & 31, hi = lane >> 5;
    const int sr = tid >> 4, sc = (tid & 15) * 8, kws = KSWZ(sr, sc * 2); char* K_lds = lds + 2 * SHM_V;
    for (int d0 = 0; d0 < 8; ++d0) S.qr[d0] = load8(cur.Q + (size_t)(wid * QBLK + r32) * PITCH + d0 * 16 + hi * 8);
    SLOAD_H(cur.K, cur.V, 0); VMW(); SWRITE_HK(0);
    __syncthreads();
}
__device__ __forceinline__ void causal_block(const BlockRef& cur, const BlockRef& nxt, char* lds, Seam& S) {
    const int tid = tid_opaque(), wid = __builtin_amdgcn_readfirstlane(tid >> 6), lane = tid & 63, r32 = lane & 31, hi = lane >> 5;
    const int W = SEQ;
    const int j_hi = (cur.P0 + QB - 1) / KVBLK + 1;
    const int NT = j_hi;
    const int qlo = cur.P0 + wid * QBLK, qm = qlo + r32 - 4 * hi;
    char* V_lds = lds; char* K_lds = lds + 2 * SHM_V;
    float* ws = (float*)(lds + 2 * SHM_V + 2 * SHM_K) + wid * 64; float* li_l = ws, * al_l = ws + 32;
    float m_reg = -1e30f, l_reg = 0; f32x16 o[4] = {};
    const int sr = tid >> 4, sc = (tid & 15) * 8, vst0 = v_st(sr, sc), vst1 = v_st(32 + sr, sc), kws = KSWZ(sr, sc * 2);
    const int vb0 = (int)(uintptr_t)V_lds + v_rd_base(lane);
    const bf16_t* Kh = cur.K; const bf16_t* Vh = cur.V;
    const float sl = cur.sl, tb0 = sl * (float)(4 * hi - cur.P0);
#define RESC(a) do { if (__any((a) < 1.f)) { if (hi == 0) al_l[r32] = (a); asm volatile("s_waitcnt lgkmcnt(0)" ::: "memory");              \
                     for (int d_ = 0; d_ < 4; ++d_) for (int r = 0; r < 16; ++r) o[d_][r] *= al_l[crow(r, hi)]; } } while (0)
#define KBASE(t) ((t) * KVBLK)
#define TB(t) fmaf(sl, (float)KBASE(t), tb0)
#define MASKT(P0_, P1_, t) do { const int kb_ = KBASE(t); if (kb_ + KVBLK - 1 > qlo) mask_tile(P0_, P1_, qm - kb_, (unsigned)W); } while (0)
    constexpr int NQL = 8;
#define SEAM_K0() do { VMWN(NQL); SWRITE_HK(0); SBAR(); } while (0)
    f32x16 pA0, pA1, pB0, pB1; float mnA, mnB, alA, alB; bf16x8 pa0, pa1, pa2, pa3;
    SWRITE_HV(0); SBAR();
    if (NT > 1) { SLOAD_H(Kh, Vh, KBASE(1)); }
    SBAR(); qkt<0>(pA0, pA1, K_lds, r32, hi, S.qr, sl, TB(0));
    MASKT(pA0, pA1, 0); partialSM(pA0, pA1, m_reg, mnA, alA);
    if (NT > 1) { VMW(); SWRITE_H(1); }
    __syncthreads();
#define HALF_STEP(PX0, PX1, mnX, alX, PY0, PY1, alY, t, KB, VB, SB) do {                                                      \
        SBAR(); qkt<KB>(PX0, PX1, K_lds, r32, hi, S.qr, sl, TB(t));                                             \
        finishSM(PY0, PY1, alY, l_reg, pa0, pa1, pa2, pa3); SBAR();                                                           \
        if ((t) + 1 < NT) { SLOAD_H(Kh, Vh, KBASE((t) + 1)); SBAR(); }                                               \
        pv_tile<VB>(o, vb0, pa0, pa1, pa2, pa3); MASKT(PX0, PX1, (t)); partialSM(PX0, PX1, m_reg, mnX, alX);                                        \
        __syncthreads();                                                                                                      \
        if ((t) + 1 < NT) { VMW(); SWRITE_H(SB); }                                                                          \
        RESC(alX); __syncthreads(); } while (0)
    for (int t = 1; t + 1 < NT; t += 2) {
        HALF_STEP(pB0, pB1, mnB, alB, pA0, pA1, alA, t, 1, 0, 0);
        HALF_STEP(pA0, pA1, mnA, alA, pB0, pB1, alB, t + 1, 0, 1, 1);
    }
    const bool even = (NT & 1) == 0;
    if (even) { SBAR(); qkt<1>(pB0, pB1, K_lds, r32, hi, S.qr, sl, TB(NT - 1)); SBAR(); }
    SLOAD_H(nxt.K, nxt.V, 0); SBAR();
#pragma unroll
    for (int d0 = 0; d0 < 8; ++d0) S.qr[d0] = load8(nxt.Q + (size_t)(wid * QBLK + r32) * PITCH + d0 * 16 + hi * 8);
    SBAR();
    finishSM(pA0, pA1, alA, l_reg, pa0, pa1, pa2, pa3); SBAR();
    pv_tile<0>(o, vb0, pa0, pa1, pa2, pa3);
    if (even) { MASKT(pB0, pB1, NT - 1); partialSM(pB0, pB1, m_reg, mnB, alB); __syncthreads(); RESC(alB);
        finishSM(pB0, pB1, alB, l_reg, pa0, pa1, pa2, pa3); SBAR(); pv_tile<1>(o, vb0, pa0, pa1, pa2, pa3); }
    SBAR(); SEAM_K0();
    if (hi == 0) li_l[r32] = l_reg; asm volatile("s_waitcnt lgkmcnt(0)" ::: "memory");
    float rli[16];
#pragma unroll
    for (int r = 0; r < 16; ++r) rli[r] = __builtin_amdgcn_rcpf(li_l[crow(r, hi)]);
    bf16_t* Ow = cur.O + (size_t)(wid * QBLK) * PITCH;
#pragma unroll
    for (int r = 0; r < 16; ++r) { const int orow = crow(r, hi);
#pragma unroll
        for (int d0 = 0; d0 < 4; ++d0) { const float v = o[d0][r] * rli[r];
            const float vn = __shfl_xor(v, 1);
            if ((r32 & 1) == 0) st4_wt(Ow + (size_t)orow * PITCH + d0 * 32 + r32, cvtpk(v, vn)); } }
    __syncthreads();
#undef RESC
#undef KBASE
#undef TB
#undef MASKT
#undef SEAM_K0
#undef HALF_STEP
}
#undef ROW
#undef VMW
#undef VMWN
#undef SLOAD_H
#undef SWRITE_HK
#undef SWRITE_HV
#undef SWRITE_H
#undef KSWZ
#undef SBAR
__device__ __forceinline__ BlockRef make_ref(unsigned char* ws, int hp, int qb) {
    const int vh = hp & 1, c = (hp >> 1) & 1, h = (hp >> 2) & 15, b = hp >> 6;
    const bf16_t* Q = (const bf16_t*)(ws + WS_Q); const bf16_t* Kp = Q + (size_t)T * AW; const bf16_t* Vp = Kp + (size_t)T * AW; bf16_t* O = (bf16_t*)(ws + WS_OC) + (size_t)c * T * AW;
    BlockRef r; const size_t tok0 = (size_t)b * SEQ;
    r.Q = Q + (tok0 + (size_t)qb * QB) * PITCH + h * 256 + c * 128; r.K = Kp + tok0 * PITCH + h * 256 + c * 128; r.V = Vp + tok0 * PITCH + h * 256 + vh * 128;
    r.O = O + (tok0 + (size_t)qb * QB) * PITCH + h * 256 + vh * 128; r.P0 = qb * QB;
    r.sl = exp2f(-0.5f * (float)(h + 1)) * (1.0f / SCALE);
    return r;
}
__device__ __forceinline__ void attn_phase(unsigned char* ws, char* lds, int G, int bid) {
    constexpr int NQB = SEQ / QB, NX = NQB / 2, TOTAL = NX * 128;
    int L = bid; if (L >= TOTAL) return;
    int pass = 0;
    BlockRef cur = make_ref(ws, L / NX, L % NX);
    Seam S;
    causal_prime(cur, lds, S);
    for (;;) {
        const bool more_pass = pass == 0, more_item = L + G < TOTAL, last = !more_pass && !more_item;
        int Ln = L, passn = pass + 1;
        if (!more_pass) { passn = 0; Ln = more_item ? L + G : L; }
        const int xq = Ln % NX; const BlockRef nxt = last ? cur : make_ref(ws, Ln / NX, passn ? NQB - 1 - xq : xq);
        causal_block(cur, nxt, lds, S);
        if (last) break;
        cur = nxt; pass = passn; L = Ln;
    }
}
}

__device__ __forceinline__ void diff_phase(Frame& F, KArgsPtr a) {
    const int lane = F.lane, gw = F.vcu * NWAVES + F.wave, NGW = F.G * NWAVES;
    float d1 = a->in[16][lane] * a->in[17][lane] + a->in[16][lane + 64] * a->in[17][lane + 64];
    float d2 = a->in[18][lane] * a->in[19][lane] + a->in[18][lane + 64] * a->in[19][lane + 64];
    const float lam = expf(wave_sum(d1)) - expf(wave_sum(d2)) + LAMBDA_INIT1;
    const bf16_t* O0 = (const bf16_t*)(F.ws + WS_OC); const bf16_t* O1 = O0 + (size_t)T * AW; bf16_t* ob = (bf16_t*)(F.ws + WS_OB);
    for (int m = gw; m < T; m += NGW) {
        const size_t base = (size_t)m * AW + 64 * lane; float v[64]; float ss = 0.f;
#pragma unroll
        for (int j = 0; j < 8; ++j) { const u32x4 x0 = *(const u32x4*)(O0 + base + 8 * j), x1 = *(const u32x4*)(O1 + base + 8 * j);
#pragma unroll
            for (int q = 0; q < 4; ++q) { const float lo = bf2f(x0[q] & 0xffffu) - lam * bf2f(x1[q] & 0xffffu), hi2 = bf2f(x0[q] >> 16) - lam * bf2f(x1[q] >> 16);
                v[8 * j + 2 * q] = lo; v[8 * j + 2 * q + 1] = hi2; ss += lo * lo + hi2 * hi2; } }
        ss += __shfl_xor(ss, 1); ss += __shfl_xor(ss, 2);
        const float rs = 1.0f / sqrtf(ss * (1.0f / 256.0f) + EPS);
#pragma unroll
        for (int j = 0; j < 8; ++j) { u32x4 w; w.x = cvt_pk_bf16(v[8 * j] * rs, v[8 * j + 1] * rs); w.y = cvt_pk_bf16(v[8 * j + 2] * rs, v[8 * j + 3] * rs);
            w.z = cvt_pk_bf16(v[8 * j + 4] * rs, v[8 * j + 5] * rs); w.w = cvt_pk_bf16(v[8 * j + 6] * rs, v[8 * j + 7] * rs); st16_wt(ob + base + 8 * j, w); }
    }
}
__device__ __forceinline__ void final_phase(Frame& F, KArgsPtr a) {
    const int lane = F.lane, gw = F.vcu * NWAVES + F.wave, NGW = F.G * NWAVES;
    const float* H = (const float*)(F.ws + WS_H); const bf16_t* Y = (const bf16_t*)(F.ws + WS_YS); const float* g = a->in[31];
    for (int m = gw; m < T; m += NGW) {
        const size_t base = (size_t)m * DM + 4 * lane; f32x4 v[16]; float ss = 0.f;
#pragma unroll
        for (int j = 0; j < 16; ++j) { f32x4 x = *(const f32x4*)(H + base + 256 * j); const u32x2 ya = *(const u32x2*)(Y + base + 256 * j), yb2 = *(const u32x2*)(Y + (size_t)T * DM + base + 256 * j);
            x.x += bf2f(ya.x & 0xffffu) + bf2f(yb2.x & 0xffffu); x.y += bf2f(ya.x >> 16) + bf2f(yb2.x >> 16); x.z += bf2f(ya.y & 0xffffu) + bf2f(yb2.y & 0xffffu); x.w += bf2f(ya.y >> 16) + bf2f(yb2.y >> 16);
            v[j] = x; ss += (x.x * x.x + x.y * x.y) + (x.z * x.z + x.w * x.w); }
        const float rs = 1.0f / sqrtf(wave_sum(ss) * (1.0f / DM) + EPS);
#pragma unroll
        for (int j = 0; j < 16; ++j) { const f32x4 gg = *(const f32x4*)(g + 4 * lane + 256 * j); *(f32x4*)(a->out + base + 256 * j) = v[j] * rs * gg; }
    }
}

constexpr int NPHASE = 17;
#ifndef DBG_ROW_WORDS
#define DBG_ROW_WORDS 1024
#endif
#ifndef DBG_COL_LO
#define DBG_COL_LO 0
#define DBG_COL_HI 4096
#endif
#ifndef PHASE_MASK
#define PHASE_MASK 0x1FFFF
#endif
#define PH_BEGIN KArgsPtr a = launder_args(kp); Frame F = make_frame(a, lds); unsigned char* ws = F.ws; (void)ws; (void)F;
__device__ __forceinline__ void ph_u_gemm(KArgsPtr kp, LAS unsigned char* lds) { PH_BEGIN
    pg8::StaticOrder S; S.init(T, SW, F.G, F.bid);
    pg8::EpiRowScaleBf16 E{(bf16_t*)(ws + WS_UB), SW, (const float*)(ws + WS_RSTD), 0, 0};
    pg8::gemm_phase<pg8::EpiRowScaleBf16, pg8::StaticOrder, false>(lds, (const bf16_t*)(ws + WS_XB), (const bf16_t*)(ws + WS_WIN), DM, S, E, nullptr); }
__device__ __forceinline__ void ph_glu_gemm(KArgsPtr kp, LAS unsigned char* lds) { PH_BEGIN
    pg8::StaticOrder S; S.init(T, 2 * DM, F.G, F.bid);
    pg8::EpiGlu E{a->in[0], (float*)(ws + WS_H)};
    pg8::gemm_phase<pg8::EpiGlu, pg8::StaticOrder, false>(lds, (const bf16_t*)(ws + WS_YB), (const bf16_t*)(ws + WS_GLU), SW, S, E, nullptr); }
__device__ __forceinline__ void ph_qkv_gemm(KArgsPtr kp, LAS unsigned char* lds) { PH_BEGIN
    pg8::StaticOrder S; S.init(T, 3 * AW, F.G, F.bid);
    pg8::EpiRowScaleBf16 E{(bf16_t*)(ws + WS_Q), AW, (const float*)(ws + WS_RSTD), AW, (size_t)T * AW};
    pg8::gemm_phase<pg8::EpiRowScaleBf16, pg8::StaticOrder, false>(lds, (const bf16_t*)(ws + WS_XB), (const bf16_t*)(ws + WS_QKV), DM, S, E, nullptr); }
__device__ __forceinline__ void ph_wo_gemm(KArgsPtr kp, LAS unsigned char* lds) { PH_BEGIN
    pg8::StaticOrder S; S.init(T, DM, F.G, F.bid);
    pg8::EpiResAdd E{(float*)(ws + WS_H)};
    pg8::gemm_phase<pg8::EpiResAdd, pg8::StaticOrder, false>(lds, (const bf16_t*)(ws + WS_OB), (const bf16_t*)(ws + WS_WO), AW, S, E, nullptr); }
__device__ __forceinline__ void ph_router(KArgsPtr kp, LAS unsigned char* lds, int li) { PH_BEGIN
    rn_phase<false, true>(F, (float*)(ws + WS_H), nullptr, (bf16_t*)(ws + WS_XB), (float*)(ws + WS_RSTD), (const float*)(ws + WS_WRT) + (size_t)li * 32 * DM, a->in[23] + li * 4, a->in[25] + li * NE,
                          F.ctl + CW_CNT + li * NE * 64, (int*)(ws + WS_LIST), (float*)(ws + WS_LIST + 512 * 1024)); }
__device__ __forceinline__ void ph_combine(KArgsPtr kp, LAS unsigned char* lds) { PH_BEGIN
    rn_phase<true, false>(F, (float*)(ws + WS_H), (const bf16_t*)(ws + WS_YS), (bf16_t*)(ws + WS_XB), (float*)(ws + WS_RSTD), nullptr, nullptr, nullptr, nullptr, nullptr, nullptr); }
__device__ __forceinline__ void ph_gateup(KArgsPtr kp, LAS unsigned char* lds, int li) { PH_BEGIN
    const int n = build_group<false>(F, F.ctl + CW_CNT + li * NE * 64, (const int*)(ws + WS_LIST), (const float*)(ws + WS_LIST + 512 * 1024), (const float*)(ws + WS_RSTD), 8, DM * 2);
    pg8::ListOrder S{(const LAS int*)(lds + TAB_OFF + 128), n};
    pg8::EpiGateUp E{(bf16_t*)(ws + WS_HM), (const LAS float*)(lds + TAB_OFF + 256 + 8 * 1024), (const LAS float*)(lds + TAB_OFF + 256 + 16 * 1024)};
    pg8::gemm_phase<pg8::EpiGateUp, pg8::ListOrder, true>(lds, (const bf16_t*)(ws + WS_XB), (const bf16_t*)(ws + WS_GU) + (size_t)li * NE * 2048 * DM, DM, S, E, (const LAS unsigned*)(lds + TAB_OFF + 256)); }
__device__ __forceinline__ void ph_down(KArgsPtr kp, LAS unsigned char* lds, int li) { PH_BEGIN
    const int n = build_group<true>(F, F.ctl + CW_CNT + li * NE * 64, (const int*)(ws + WS_LIST), (const float*)(ws + WS_LIST + 512 * 1024), (const float*)(ws + WS_RSTD), 16, 0);
    pg8::ListOrder S{(const LAS int*)(lds + TAB_OFF + 128), n};
    pg8::EpiDown E{(bf16_t*)(ws + WS_YS), (const LAS unsigned*)(lds + TAB_OFF + 256)};
    pg8::gemm_phase<pg8::EpiDown, pg8::ListOrder, false>(lds, (const bf16_t*)(ws + WS_HM), (const bf16_t*)(ws + WS_DN) + (size_t)li * NE * DM * FF, FF, S, E, nullptr); }
__device__ __forceinline__ void ph_prologue(KArgsPtr kp, LAS unsigned char* lds) { PH_BEGIN p0_prologue(F, a); }
__device__ __forceinline__ void ph_scan1(KArgsPtr kp, LAS unsigned char* lds) { PH_BEGIN
    scan_phase<1>(F, a); }
__device__ __forceinline__ void ph_scan2(KArgsPtr kp, LAS unsigned char* lds) { PH_BEGIN scan_phase<2>(F, a); }
__device__ __forceinline__ void ph_attn(KArgsPtr kp, LAS unsigned char* lds) { PH_BEGIN att::attn_phase(ws, (char*)lds, F.G, F.bid); }
__device__ __forceinline__ void ph_diff(KArgsPtr kp, LAS unsigned char* lds) { PH_BEGIN diff_phase(F, a); }
__device__ __forceinline__ void ph_final(KArgsPtr kp, LAS unsigned char* lds) { PH_BEGIN final_phase(F, a); }

__device__ __forceinline__ void ph_debug(KArgsPtr kp0, LAS unsigned char* lds) {
    KArgsPtr kp = launder_args(kp0);

        XcdBarrier b; b.bar = (unsigned*)(kp->ws + WS_CTL) + CW_BAR; b.x = xb_xcc_id(); b.st = (volatile LAS unsigned*)(lds + MISC_OFF) + 8; xcd_barrier(b);
        const int dtid = tid_opaque(), dbid = bid_opaque(), dgrid = grid_opaque();
        if (kp->dbg_kind == 12) { const float* dbg = (const float*)(kp->ws + WS_OC); float* o12 = kp->out; _Pragma("nounroll") for (size_t i = (size_t)dbid * 512 + dtid; i < (size_t)T * DM; i += (size_t)dgrid * 512) o12[i] = dbg[i & 2047]; return; }
        if (kp->dbg_kind == 10) {
            const int lane = dtid & 63, gw = dbid * 8 + (dtid >> 6), ngw = dgrid * 8; float* o10 = kp->out;
            _Pragma("nounroll") for (int r = gw; r < T; r += ngw) { const unsigned* p = (const unsigned*)(kp->ws + kp->dbg_off) + (size_t)r * DBG_ROW_WORDS; unsigned c = 0;
                _Pragma("nounroll") for (int j = lane; j < DBG_ROW_WORDS; j += 64) { const unsigned w = p[j]; c += (w ^ (w >> 16)) * 2654435761u; c = (c << 5) | (c >> 27); }
                for (int off2 = 1; off2 < 64; off2 <<= 1) c += __shfl_xor(c, off2);
                const float v = (float)(c & 0xFFFFu);
                _Pragma("nounroll") for (int j = lane; j < DM; j += 64) o10[(size_t)r * DM + j] = v; }
            return; }
        const size_t n = (size_t)T * DM; float* o = kp->out;
        _Pragma("nounroll") for (size_t i = (size_t)dbid * 512 + dtid; i < n; i += (size_t)dgrid * 512) {
            if (kp->dbg_kind == 9) { o[i] = (float)(((const unsigned*)kp->in[0])[i] & 0xFFFFu); }
            else if (kp->dbg_kind == 7) { o[i] = (float)(((const unsigned*)(kp->ws + kp->dbg_off))[i] & 0xFFFFu); }
            else if (kp->dbg_kind == 6) { o[i] = ((const float*)(kp->ws + WS_H))[i] - kp->in[0][i]; }
            else if (kp->dbg_kind == 5) { const bf16_t* q = (const bf16_t*)(kp->ws + WS_Q); o[i] = bf2f(q[i]) + 2.f * bf2f(q[i + n]) + 4.f * bf2f(q[i + 2 * n]); }
            else if (kp->dbg_kind == 4) { const int col = (int)(i % DM); o[i] = (col >= DBG_COL_LO && col < DBG_COL_HI) ? bf2f(((const bf16_t*)(kp->ws + kp->dbg_off))[i]) : 0.f; }
            else if (kp->dbg_kind == 1) o[i] = bf2f(((const bf16_t*)(kp->ws + kp->dbg_off))[i]); else o[i] = ((const float*)(kp->ws + kp->dbg_off))[i]; }

}
__device__ __forceinline__ bool ph_in(KArgsPtr kp, int k) { asm volatile("" : "+s"(kp)); return kp->ph_lo <= k && k < kp->ph_hi; }
__device__ __forceinline__ void ph_seam(KArgsPtr kp, LAS unsigned char* lds, int k) {
    asm volatile("" : "+s"(kp));
    if (kp->ph_lo <= k && k + 1 < kp->ph_hi) { XcdBarrier b; b.bar = (unsigned*)(kp->ws + WS_CTL) + CW_BAR; b.x = xb_xcc_id(); b.st = (volatile LAS unsigned*)(lds + MISC_OFF) + 8; xcd_barrier(b);
#ifdef DOUBLE_BARRIER
        for (int extra = 1; extra < DOUBLE_BARRIER; ++extra) xcd_barrier(b);
#endif
    }
}
__global__ void __launch_bounds__(NWAVES * 64, 2) yoco_fwd(Args args) {
    extern __shared__ __attribute__((aligned(16))) unsigned char lds_raw[];
    LAS unsigned char* lds = (LAS unsigned char*)lds_raw;
    KArgsPtr kp = (KArgsPtr)__builtin_amdgcn_kernarg_segment_ptr();
#ifdef DBG_DELAY_TICKS
    { const unsigned long long t0 = __builtin_amdgcn_s_memrealtime(); while (__builtin_amdgcn_s_memrealtime() - t0 < (unsigned long long)DBG_DELAY_TICKS) __builtin_amdgcn_s_sleep(10); }
#endif
    { volatile LAS unsigned* MISC = (volatile LAS unsigned*)(lds + MISC_OFF);
      if (threadIdx.x < 64) MISC[threadIdx.x] = 0u;
      __syncthreads();
      (void)xcd_barrier_post((unsigned*)(args.ws + WS_CTL) + CW_BAR, MISC + 8); }
#define IN(k) (((PHASE_MASK >> ((k) & 31)) & 1) && ph_in(kp, (k)))
#define SEAM(k) ph_seam(kp, lds, (k))
    if (IN(0)) ph_prologue(kp, lds); SEAM(0);
    if (IN(1)) ph_u_gemm(kp, lds); SEAM(1);
    if (IN(2)) ph_scan1(kp, lds); SEAM(2);
    if (IN(3)) ph_scan2(kp, lds); SEAM(3);
    if (IN(4)) ph_glu_gemm(kp, lds); SEAM(4);
    if (IN(5)) ph_router(kp, lds, 0); SEAM(5);
    if (IN(6)) ph_gateup(kp, lds, 0); SEAM(6);
    if (IN(7)) ph_down(kp, lds, 0); SEAM(7);
    if (IN(8)) ph_combine(kp, lds); SEAM(8);
    if (IN(9)) ph_qkv_gemm(kp, lds); SEAM(9);
    if (IN(10)) ph_attn(kp, lds); SEAM(10);
    if (IN(11)) ph_diff(kp, lds); SEAM(11);
    if (IN(12)) ph_wo_gemm(kp, lds); SEAM(12);
    if (IN(13)) ph_router(kp, lds, 1); SEAM(13);
    if (IN(14)) ph_gateup(kp, lds, 1); SEAM(14);
    if (IN(15)) ph_down(kp, lds, 1); SEAM(15);
    if (IN(16)) ph_final(kp, lds);
    if (kp->dbg_kind) ph_debug(kp, lds);
#undef IN
#undef SEAM
}

#ifndef MK_N_LAUNCHES
#define MK_N_LAUNCHES 1
#endif
extern "C" void kernel_launch(void* const* d_in, const int* in_sizes, int n_in, void* d_out, int out_size, void* d_ws, size_t ws_size, hipStream_t stream) {
    static int grid = 0;
    if (grid == 0) {
        if (n_in != 32 || out_size != T * DM || ws_size < WS_END) { fprintf(stderr, "kernel_launch: unexpected shapes (n_in %d out %d ws %zu)\n", n_in, out_size, ws_size); grid = -1; return; }
        int dev = 0, cus = 0, per_cu = 0;
        if (hipGetDevice(&dev) != hipSuccess || hipDeviceGetAttribute(&cus, hipDeviceAttributeMultiprocessorCount, dev) != hipSuccess) { grid = -1; return; }
        if (hipFuncSetAttribute((const void*)yoco_fwd, hipFuncAttributeMaxDynamicSharedMemorySize, LDS_BYTES) != hipSuccess) { fprintf(stderr, "kernel_launch: hipFuncSetAttribute failed\n"); grid = -1; return; }
        if (hipOccupancyMaxActiveBlocksPerMultiprocessor(&per_cu, (const void*)yoco_fwd, NWAVES * 64, LDS_BYTES) != hipSuccess || per_cu < 1) fprintf(stderr, "kernel_launch: occupancy query says %d\n", per_cu);
        (void)hipGetLastError();
        grid = cus;
    }
    if (grid < 0) return;
    (void)hipMemsetAsync((char*)d_ws + WS_CTL, 0, CTL_ZERO_BYTES, stream);
#ifdef DBG_ZERO_YS
    (void)hipMemsetAsync((char*)d_ws + WS_YS, 0, (size_t)2 * T * DM * 2, stream);
#endif
    Args a{};
    for (int i = 0; i < 32; ++i) a.in[i] = (const float*)d_in[i];
    a.out = (float*)d_out; a.ws = (unsigned char*)d_ws;
#ifdef DBG_STOP
    a.ph_lo = 0; a.ph_hi = DBG_STOP + 1; a.dbg_kind = DBG_KIND; a.dbg_off = (size_t)DBG_OFF_MIB * MiB;
    hipLaunchKernelGGL(yoco_fwd, dim3(grid), dim3(NWAVES * 64), LDS_BYTES, stream, a);
#elif MK_N_LAUNCHES == 1
    a.ph_lo = 0; a.ph_hi = NPHASE;
    hipLaunchKernelGGL(yoco_fwd, dim3(grid), dim3(NWAVES * 64), LDS_BYTES, stream, a);
#else
    for (int p = 0; p < NPHASE; ++p) { a.ph_lo = p; a.ph_hi = p + 1; hipLaunchKernelGGL(yoco_fwd, dim3(grid), dim3(NWAVES * 64), LDS_BYTES, stream, a); }
#endif
}
```

```cpp
#define DOUBLE_BARRIER 2
#define GEMM_DRAIN0 0
#include <hip/hip_runtime.h>
#include <cstdio>
#include <cstdint>

#define LAS __attribute__((address_space(3)))
#define GAS __attribute__((address_space(1)))
typedef unsigned short bf16_t;
typedef short bf16x8 __attribute__((ext_vector_type(8)));
typedef short s16x4 __attribute__((ext_vector_type(4)));
typedef float f32x4 __attribute__((ext_vector_type(4)));
typedef float f32x2 __attribute__((ext_vector_type(2)));
typedef float f32x16 __attribute__((ext_vector_type(16)));
typedef unsigned u32x4 __attribute__((ext_vector_type(4)));
typedef unsigned u32x2 __attribute__((ext_vector_type(2)));

constexpr int BATCH = 2, SEQ = 4096, T = BATCH * SEQ, DM = 4096;
constexpr int SW = 2048, NG = 128, SJ = 16, SP = 64;
constexpr int NH = 16, HD = 128, AW = 4096;
constexpr int NE = 16, FF = 1024;
constexpr float EPS = 1e-6f;
constexpr float LAMBDA_INIT1 = 0.35550906759f;
constexpr int NSEG = 8, LSEG = SEQ / NSEG;

constexpr size_t MiB = 1u << 20;
constexpr size_t WS_CTL = 0, CTL_ZERO_BYTES = 1 * MiB;
constexpr size_t WS_WIN = 16 * MiB;
constexpr size_t WS_GLU = 32 * MiB;
constexpr size_t WS_QKV = 64 * MiB;
constexpr size_t WS_WO = 160 * MiB;
constexpr size_t WS_GU = 192 * MiB;
constexpr size_t WS_DN = 704 * MiB;
constexpr size_t WS_WRT = 960 * MiB;
constexpr size_t WS_RSTD = 961 * MiB;
constexpr size_t WS_LIST = 962 * MiB;
constexpr size_t WS_ENDS = 963 * MiB;
constexpr size_t WS_XB = 964 * MiB;
constexpr size_t WS_UB = 1028 * MiB;
constexpr size_t WS_YB = 1060 * MiB;
constexpr size_t WS_H = 1092 * MiB;
constexpr size_t WS_Q = 1220 * MiB;
constexpr size_t WS_OC = 1412 * MiB;
constexpr size_t WS_OB = 1540 * MiB;
constexpr size_t WS_YS = 1604 * MiB;
constexpr size_t WS_HM = 1732 * MiB;
constexpr size_t WS_END = 1772 * MiB;
constexpr int CW_BAR = 4096;
constexpr int CW_CNT = 16384;
constexpr int LISTCAP = 8192;

constexpr int RING_BYTES = 131072;
constexpr int MISC_OFF = RING_BYTES;
constexpr int TAB_OFF = RING_BYTES + 256;
constexpr int LDS_BYTES = 163840;
constexpr int NWAVES = 8;

#define LDS_WAIT() asm volatile("s_waitcnt lgkmcnt(0)" ::: "memory")
#define VM_WAIT() asm volatile("s_waitcnt vmcnt(0)" ::: "memory")
__device__ __forceinline__ unsigned f2bf(float f) { unsigned u = __builtin_bit_cast(unsigned, f); return (u + 0x7fffu + ((u >> 16) & 1u)) >> 16; }
__device__ __forceinline__ float bf2f(unsigned b) { return __builtin_bit_cast(float, b << 16); }
__device__ __forceinline__ unsigned cvt_pk_bf16(float lo, float hi) { unsigned r; asm volatile("v_cvt_pk_bf16_f32 %0, %1, %2" : "=v"(r) : "v"(lo), "v"(hi)); return r; }
__device__ __forceinline__ float wave_sum(float v) {
#pragma unroll
    for (int o = 1; o < 64; o <<= 1) v += __shfl_xor(v, o);
    return v;
}
__device__ __forceinline__ int tid_opaque() { int t = threadIdx.x; asm volatile("" : "+v"(t)); return t; }
__device__ __forceinline__ int bid_opaque() { int b = blockIdx.x; asm volatile("" : "+s"(b)); return b; }
__device__ __forceinline__ int grid_opaque() { int g = gridDim.x; asm volatile("" : "+s"(g)); return g; }
__device__ __forceinline__ float ld_coh(const float* p) { return __builtin_bit_cast(float, __hip_atomic_load((const unsigned*)p, __ATOMIC_RELAXED, __HIP_MEMORY_SCOPE_AGENT)); }
__device__ __forceinline__ int ld_coh(const int* p) { return (int)__hip_atomic_load((const unsigned*)p, __ATOMIC_RELAXED, __HIP_MEMORY_SCOPE_AGENT); }
__device__ __forceinline__ void st_coh(float* p, float v) { __hip_atomic_store((unsigned*)p, __builtin_bit_cast(unsigned, v), __ATOMIC_RELAXED, __HIP_MEMORY_SCOPE_AGENT); }
__device__ __forceinline__ void st_coh(int* p, int v) { __hip_atomic_store((unsigned*)p, (unsigned)v, __ATOMIC_RELAXED, __HIP_MEMORY_SCOPE_AGENT); }
__device__ __forceinline__ void st16_wt(void* p, u32x4 v) { asm volatile("global_store_dwordx4 %0, %1, off sc1\n\ts_nop 1" :: "v"(p), "v"(v) : "memory"); }
__device__ __forceinline__ void st16_wt(void* p, f32x4 v) { st16_wt(p, __builtin_bit_cast(u32x4, v)); }
__device__ __forceinline__ void st8_wt(void* p, u32x2 v) { asm volatile("global_store_dwordx2 %0, %1, off sc1\n\ts_nop 1" :: "v"(p), "v"(v) : "memory"); }
__device__ __forceinline__ void st4_wt(void* p, unsigned v) { asm volatile("global_store_dword %0, %1, off sc1\n\ts_nop 1" :: "v"(p), "v"(v) : "memory"); }
__device__ __forceinline__ void st2_wt(void* p, unsigned v) { asm volatile("global_store_short %0, %1, off sc1\n\ts_nop 1" :: "v"(p), "v"(v) : "memory"); }
__device__ __forceinline__ float fast_sigmoid(float x) { return __builtin_amdgcn_rcpf(1.0f + __expf(-x)); }

#define XB_TMO      128
#define XB_XCNT(j)  (256  + 64 * (j))
#define XB_XSUB(j)  (1280 + 64 * (j))
#define XB_XGEN(j)  (2304 + 64 * (j))
#define XB_TOP      3328
#define XB_TOPGEN   3392
#define XCD_BAR_WORDS 3456
#define XB_SPIN_CAP (1u << 18)
__device__ __forceinline__ unsigned xb_ld(unsigned* p)              { return __hip_atomic_load(p, __ATOMIC_RELAXED, __HIP_MEMORY_SCOPE_AGENT); }
__device__ __forceinline__ unsigned xb_add(unsigned* p, unsigned v) { return __hip_atomic_fetch_add(p, v, __ATOMIC_RELAXED, __HIP_MEMORY_SCOPE_AGENT); }
__device__ __forceinline__ unsigned xb_xcc_id() { return (unsigned)__builtin_amdgcn_s_getreg((3 << 11) | 20) & 0xFu; }
#define XB_SPIN(cond, bar) do { unsigned _sp = 0; while (cond) { __builtin_amdgcn_s_sleep(1); \
    if ((++_sp & 255u) == 0u) { if (xb_ld(&(bar)[XB_TMO])) break; if (_sp > XB_SPIN_CAP) { atomicAdd(&(bar)[XB_TMO], 1u); break; } } } } while (0)
struct XcdBarrier { unsigned* bar; unsigned x; volatile LAS unsigned* st; };
__device__ __forceinline__ XcdBarrier xcd_barrier_post(unsigned* bar, volatile LAS unsigned* st) {
    XcdBarrier b; b.bar = bar; b.x = xb_xcc_id(); b.st = st;
    if (threadIdx.x == 0) (void)xb_add(&bar[XB_XCNT(b.x)], 1u);
    return b;
}
__device__ __forceinline__ void xcd_barrier_complete(unsigned* bar, unsigned x, unsigned& nloc, unsigned& nx) {
    const unsigned G = gridDim.x * gridDim.y * gridDim.z;
    unsigned sum, cnt, mine, sp = 0u;
    for (;;) {
        sum = 0u; cnt = 0u; mine = 0u;
#pragma unroll
        for (unsigned j = 0; j < 16; ++j) { const unsigned c = xb_ld(&bar[XB_XCNT(j)]); sum += c; cnt += (c > 0u) ? 1u : 0u; mine = (j == x) ? c : mine; }
        if (sum == G) break;
        __builtin_amdgcn_s_sleep(1);
        if ((++sp & 255u) == 0u) { if (xb_ld(&bar[XB_TMO])) break; if (sp > XB_SPIN_CAP) { atomicAdd(&bar[XB_TMO], 1u); break; } }
    }
    nloc = mine > 0u ? mine : 1u; nx = cnt > 0u ? cnt : 1u;
}
__device__ __forceinline__ void xcd_barrier(const XcdBarrier& b) {
    asm volatile("s_waitcnt vmcnt(0)" ::: "memory");
    __syncthreads();
    if (threadIdx.x == 0) {
        unsigned* bar = b.bar;
        __builtin_amdgcn_s_waitcnt(0);
        unsigned nloc = b.st[0], nx = b.st[1];
        if (nloc == 0u) { xcd_barrier_complete(bar, b.x, nloc, nx); b.st[0] = nloc; b.st[1] = nx; }
        const unsigned old = xb_add(&bar[XB_XSUB(b.x)], 1u);
        const unsigned gen = old / nloc;
        if (old + 1u == (gen + 1u) * nloc) {
            __builtin_amdgcn_fence(__ATOMIC_RELEASE, "");
            asm volatile("s_waitcnt vmcnt(0)" ::: "memory");
            const unsigned og = xb_add(&bar[XB_TOP], 1u);
            const unsigned tg = og / nx;
            if (og + 1u == (tg + 1u) * nx) xb_add(&bar[XB_TOPGEN], 1u);
            else XB_SPIN(xb_ld(&bar[XB_TOPGEN]) == tg, bar);
            __builtin_amdgcn_fence(__ATOMIC_ACQUIRE, "");
            xb_add(&bar[XB_XGEN(b.x)], 1u);
            asm volatile("s_waitcnt vmcnt(0)" ::: "memory");
        } else {
            XB_SPIN(xb_ld(&bar[XB_XGEN(b.x)]) == gen, bar);
            __builtin_amdgcn_fence(__ATOMIC_ACQUIRE, "");
            asm volatile("s_waitcnt vmcnt(0)" ::: "memory");
        }
    }
    __syncthreads();
}

#ifndef GEMM_DRAIN0
#define GEMM_DRAIN0 0
#endif
namespace pg8 {
constexpr int BM = 256, BK = 64, HALF = 128, HTB = HALF * BK * 2, NXCD = 8, WGM = 8;
__device__ __forceinline__ int lds_byte(int r, int c) { const int st = (r >> 4) * 2 + (c >> 5), rr = r & 15, cc = c & 31, ob = rr * 64 + cc * 2; return st * 1024 + (ob ^ (((ob >> 9) & 1) << 5)); }
__device__ __forceinline__ void stage_rc(int b, int& R, int& C) { const int st = b / 1024, sb = b % 1024, swz = sb ^ (((sb >> 9) & 1) << 5); R = (st >> 1) * 16 + swz / 64; C = (st & 1) * 32 + (swz % 64) / 2; }
__device__ __forceinline__ int perm32(int rho) { const int n = rho >> 4, i = rho & 15; return 8 * (i >> 2) + 4 * n + (i & 3); }
struct Unit { int pm, pn, bt; };
__device__ __forceinline__ void tile_of(int L, int nM, int nN, int& pm, int& pn) {
    const int nwg = nM * nN; int wgid = L;
    { const int q = nwg / NXCD, r = nwg % NXCD, xcd = wgid % NXCD, off = wgid / NXCD; wgid = (xcd < r ? xcd * (q + 1) : r * (q + 1) + (xcd - r) * q) + off; }
    const int nig = WGM * nN, gid = wgid / nig, fm = gid * WGM, gsz = (nM - fm) < WGM ? (nM - fm) : WGM;
    pm = fm + ((wgid % nig) % gsz); pn = (wgid % nig) / gsz;
}
struct StaticOrder {
    int nM, nN, nwg, G, c;
    __device__ void init(int M, int N, int G_, int c_) { nM = M / BM; nN = N / BM; nwg = nM * nN; G = G_; c = c_; }
    __device__ __forceinline__ bool next(int i, Unit& u) const {
        const long L = (long)i * G + c; if (L >= nwg) return false;
        tile_of((int)L, nM, nN, u.pm, u.pn); u.bt = u.pn; return true;
    }
};
struct ListOrder {
    const LAS int* ul; int n;
    __device__ __forceinline__ bool next(int i, Unit& u) const {
        if (i >= n) return false;
        u.pm = __builtin_amdgcn_readfirstlane(ul[3 * i]); u.pn = __builtin_amdgcn_readfirstlane(ul[3 * i + 1]); u.bt = __builtin_amdgcn_readfirstlane(ul[3 * i + 2]); return true;
    }
};

template <class Epi, class Sched, bool GATHER>
__device__ __forceinline__ void gemm_phase(LAS unsigned char* lds, const bf16_t* Abase, const bf16_t* Btbase, const int K, const Sched& S, const Epi& E, const LAS unsigned* gtab) {
    const int tid = tid_opaque(), wid = __builtin_amdgcn_readfirstlane(tid >> 6), lane = tid & 63, wr = wid >> 2, wc = wid & 3, fr = lane & 15, fq = lane >> 4;
    const int nt = K / BK;
    unsigned voffA[2], voffB[2]; int RA[2], CA2[2];
#pragma unroll
    for (int i = 0; i < 2; ++i) { int R, C; stage_rc(tid * 16 + i * 8192, R, C); const int Rb = Epi::PERM ? ((R & ~31) + perm32(R & 31)) : R;
        voffA[i] = (unsigned)(R * K + C) * 2u; voffB[i] = (unsigned)(Rb * K + C) * 2u; RA[i] = R; CA2[i] = C * 2; }
    const size_t kstep = (size_t)(BK * 2);
    const size_t hstep = (size_t)HALF * K * 2;
    const size_t tstep = 2 * hstep;
    const unsigned ldsw = (unsigned)wid * 1024u;
    const int aoff = lds_byte(wr * 64 + fr, fq * 8), boff = lds_byte(wc * 32 + fr, fq * 8);
#define PG8_SA(b, h) (((b) * 2 + (h)) * HTB)
#define PG8_SB(b, h) ((4 + (b) * 2 + (h)) * HTB)
#define PG8_STAGE(bufoff, gbase, voff) do { _Pragma("unroll") for (int _i = 0; _i < 2; ++_i) \
        __builtin_amdgcn_global_load_lds((const unsigned*)((const char*)(gbase) + (voff)[_i]), (LAS unsigned*)(lds + (bufoff) + ldsw + _i * 8192), 16, 0, 0); } while (0)
#define PG8_STGA(bufoff, ptr, h, goff) do { if constexpr (GATHER) { PG8_STAGE(bufoff, ptr, goff[h]); } else { PG8_STAGE(bufoff, (ptr) + (h) * hstep, voffA); } } while (0)
#define PG8_LDA(dst, b, h) do { _Pragma("unroll") for (int m = 0; m < 4; ++m) _Pragma("unroll") for (int k = 0; k < 2; ++k) dst[m][k] = *(const LAS bf16x8*)(lds + PG8_SA(b, h) + aoff + m * 2048 + k * 1024); } while (0)
#define PG8_LDB(dst, b, h) do { _Pragma("unroll") for (int n = 0; n < 2; ++n) _Pragma("unroll") for (int k = 0; k < 2; ++k) dst[n][k] = *(const LAS bf16x8*)(lds + PG8_SB(b, h) + boff + n * 2048 + k * 1024); } while (0)
#define PG8_MMA(ai, bj, At, Bt) do { __builtin_amdgcn_s_setprio(1); _Pragma("unroll") for (int m = 0; m < 4; ++m) _Pragma("unroll") for (int n = 0; n < 2; ++n) _Pragma("unroll") for (int k = 0; k < 2; ++k) \
        acc[ai][bj][m][n] = __builtin_amdgcn_mfma_f32_16x16x32_bf16(Bt[n][k], At[m][k], acc[ai][bj][m][n], 0, 0, 0); __builtin_amdgcn_s_setprio(0); } while (0)
#define PG8_WAIT_V(n) asm volatile("s_waitcnt vmcnt(" #n ")" ::: "memory")
#define PG8_WAIT_L(n) asm volatile("s_waitcnt lgkmcnt(" #n ")" ::: "memory")
#define PG8_BAR __builtin_amdgcn_s_barrier()
#define PG8_SCHED __builtin_amdgcn_sched_barrier(0)
    Unit cur, nxt; int ui = 0;
    if (!S.next(0, cur)) return;
    f32x4 acc[2][2][4][2];
#pragma unroll
    for (int a = 0; a < 2; ++a)
#pragma unroll
        for (int b = 0; b < 2; ++b)
#pragma unroll
            for (int m = 0; m < 4; ++m)
#pragma unroll
                for (int n = 0; n < 2; ++n) acc[a][b][m][n] = (f32x4){0.f, 0.f, 0.f, 0.f};
    bf16x8 At[4][2], B0[2][2], B1[2][2];
    unsigned gC[2][2], gN[2][2];
    if constexpr (GATHER) {
#pragma unroll
        for (int h = 0; h < 2; ++h)
#pragma unroll
            for (int i = 0; i < 2; ++i) { gC[h][i] = gtab[0 * 256 + h * HALF + RA[i]] + (unsigned)CA2[i]; gN[h][i] = gC[h][i]; }
    }
    const char* cA = GATHER ? (const char*)Abase : (const char*)Abase + (size_t)cur.pm * tstep; const char* cB = (const char*)Btbase + (size_t)cur.bt * tstep;
    PG8_STAGE(PG8_SB(0, 0), cB, voffB); PG8_STAGE(PG8_SB(0, 1), cB + hstep, voffB); PG8_STGA(PG8_SA(0, 0), cA, 0, gC); PG8_STGA(PG8_SA(0, 1), cA, 1, gC);
    if (wr == 1) PG8_BAR;
#if GEMM_DRAIN0
    PG8_WAIT_V(0); PG8_BAR;
#else
    PG8_WAIT_V(2); PG8_BAR;
#endif
    PG8_STAGE(PG8_SB(1, 0), cB + kstep, voffB); PG8_STGA(PG8_SA(1, 0), cA + kstep, 0, gC); PG8_STAGE(PG8_SB(1, 1), cB + hstep + kstep, voffB);
#if GEMM_DRAIN0
    PG8_WAIT_V(0); PG8_BAR;
#else
    PG8_WAIT_V(6); PG8_BAR;
#endif
    for (;;) {
        const bool has_next = S.next(ui + 1, nxt);
        const char* nA = GATHER ? (const char*)Abase : (has_next ? (const char*)Abase + (size_t)nxt.pm * tstep : cA); const char* nB = has_next ? (const char*)Btbase + (size_t)nxt.bt * tstep : cB;
        if constexpr (GATHER) {
            if (has_next) {
#pragma unroll
                for (int h = 0; h < 2; ++h)
#pragma unroll
                    for (int i = 0; i < 2; ++i) gN[h][i] = gtab[(ui + 1) * 256 + h * HALF + RA[i]] + (unsigned)CA2[i];
            } else {
#pragma unroll
                for (int h = 0; h < 2; ++h)
#pragma unroll
                    for (int i = 0; i < 2; ++i) gN[h][i] = gC[h][i];
            }
        }
        for (int t = 0; t < nt; t += 2) {
            const bool last = (t == nt - 2);
            const char* a1 = cA + (size_t)(t + 1) * kstep;
            const char* a2 = last ? nA : cA + (size_t)(t + 2) * kstep; const char* b2 = last ? nB : cB + (size_t)(t + 2) * kstep;
            const char* a3 = a2 + kstep; const char* b3 = b2 + kstep;
            unsigned g2[2][2];
            if constexpr (GATHER) {
#pragma unroll
                for (int h = 0; h < 2; ++h)
#pragma unroll
                    for (int i = 0; i < 2; ++i) g2[h][i] = last ? gN[h][i] : gC[h][i];
            }
#if GEMM_DRAIN0
            PG8_LDB(B0, 0, 0); PG8_LDB(B1, 0, 1); PG8_SCHED; PG8_LDA(At, 0, 0); PG8_WAIT_V(0); PG8_STGA(PG8_SA(1, 1), a1, 1, gC);
            PG8_WAIT_L(0); PG8_BAR; PG8_MMA(0, 0, At, B0); PG8_MMA(0, 1, At, B1); PG8_BAR; PG8_SCHED;
            PG8_LDA(At, 0, 1); PG8_WAIT_V(0); PG8_STAGE(PG8_SB(0, 0), b2, voffB); PG8_STAGE(PG8_SB(0, 1), b2 + hstep, voffB); PG8_STGA(PG8_SA(0, 0), a2, 0, g2);
            PG8_WAIT_L(0); PG8_BAR; PG8_MMA(1, 0, At, B0); PG8_MMA(1, 1, At, B1); PG8_BAR; PG8_SCHED;
            PG8_LDB(B0, 1, 0); PG8_LDB(B1, 1, 1); PG8_SCHED; PG8_LDA(At, 1, 0); PG8_WAIT_V(0); PG8_STGA(PG8_SA(0, 1), a2, 1, g2);
            PG8_WAIT_L(0); PG8_BAR; PG8_MMA(0, 0, At, B0); PG8_MMA(0, 1, At, B1); PG8_BAR; PG8_SCHED;
            PG8_LDA(At, 1, 1); PG8_WAIT_V(0); PG8_STAGE(PG8_SB(1, 0), b3, voffB); PG8_STAGE(PG8_SB(1, 1), b3 + hstep, voffB); PG8_STGA(PG8_SA(1, 0), a3, 0, g2);
            PG8_WAIT_L(0); PG8_BAR; PG8_MMA(1, 0, At, B0); PG8_MMA(1, 1, At, B1); PG8_BAR; PG8_SCHED;
#else
            PG8_LDB(B0, 0, 0); PG8_LDB(B1, 0, 1); PG8_SCHED; PG8_LDA(At, 0, 0); PG8_STGA(PG8_SA(1, 1), a1, 1, gC);
            PG8_WAIT_V(8); PG8_WAIT_L(0); PG8_BAR; PG8_MMA(0, 0, At, B0); PG8_MMA(0, 1, At, B1); PG8_BAR; PG8_SCHED;
            PG8_LDA(At, 0, 1); PG8_STAGE(PG8_SB(0, 0), b2, voffB); PG8_STAGE(PG8_SB(0, 1), b2 + hstep, voffB); PG8_STGA(PG8_SA(0, 0), a2, 0, g2);
            PG8_WAIT_V(8); PG8_WAIT_L(0); PG8_BAR; PG8_MMA(1, 0, At, B0); PG8_MMA(1, 1, At, B1); PG8_BAR; PG8_SCHED;
            PG8_LDB(B0, 1, 0); PG8_LDB(B1, 1, 1); PG8_SCHED; PG8_LDA(At, 1, 0); PG8_STGA(PG8_SA(0, 1), a2, 1, g2);
            PG8_WAIT_V(8); PG8_WAIT_L(0); PG8_BAR; PG8_MMA(0, 0, At, B0); PG8_MMA(0, 1, At, B1); PG8_BAR; PG8_SCHED;
            PG8_LDA(At, 1, 1); PG8_STAGE(PG8_SB(1, 0), b3, voffB); PG8_STAGE(PG8_SB(1, 1), b3 + hstep, voffB); PG8_STGA(PG8_SA(1, 0), a3, 0, g2);
            PG8_WAIT_V(8); PG8_WAIT_L(0); PG8_BAR; PG8_MMA(1, 0, At, B0); PG8_MMA(1, 1, At, B1); PG8_BAR; PG8_SCHED;
#endif
        }
        if (wr == 0) PG8_BAR;
        E(acc, cur, ui, wr, wc, fr, fq);
        if (!has_next) break;
#pragma unroll
        for (int a = 0; a < 2; ++a)
#pragma unroll
            for (int b = 0; b < 2; ++b)
#pragma unroll
                for (int m = 0; m < 4; ++m)
#pragma unroll
                    for (int n = 0; n < 2; ++n) acc[a][b][m][n] = (f32x4){0.f, 0.f, 0.f, 0.f};
        cur = nxt; cA = nA; cB = nB; ++ui;
        if constexpr (GATHER) {
#pragma unroll
            for (int h = 0; h < 2; ++h)
#pragma unroll
                for (int i = 0; i < 2; ++i) gC[h][i] = gN[h][i];
        }
        if (wr == 1) PG8_BAR;
    }
    PG8_WAIT_V(0);
    PG8_BAR;
#undef PG8_SA
#undef PG8_SB
#undef PG8_STAGE
#undef PG8_STGA
#undef PG8_LDA
#undef PG8_LDB
#undef PG8_MMA
#undef PG8_WAIT_V
#undef PG8_WAIT_L
#undef PG8_BAR
#undef PG8_SCHED
}

typedef f32x4 Acc[2][2][4][2];
struct EpiRowScaleBf16 {
    static constexpr bool PERM = true;
    bf16_t* O; int ldc; const float* rs; int split_cols; size_t split_stride;
    __device__ __forceinline__ void operator()(const Acc& acc, const Unit& u, int, int wr, int wc, int fr, int fq) const {
        const int row0 = u.pm * BM + wr * 64 + fr; int colt = u.pn * BM; bf16_t* base = O;
        if (split_cols) { const int t = colt / split_cols; base += (size_t)t * split_stride; colt -= t * split_cols; }
        const int col0 = colt + wc * 32 + 8 * fq;
#pragma unroll
        for (int ai = 0; ai < 2; ++ai)
#pragma unroll
            for (int m = 0; m < 4; ++m) { const int row = row0 + ai * HALF + m * 16; const float s = ld_coh(rs + row); bf16_t* rowp = base + (size_t)row * ldc + col0;
#pragma unroll
                for (int bj = 0; bj < 2; ++bj) { const f32x4 v0 = acc[ai][bj][m][0] * s, v1 = acc[ai][bj][m][1] * s;
                    u32x4 w; w.x = cvt_pk_bf16(v0[0], v0[1]); w.y = cvt_pk_bf16(v0[2], v0[3]); w.z = cvt_pk_bf16(v1[0], v1[1]); w.w = cvt_pk_bf16(v1[2], v1[3]);
                    st16_wt(rowp + bj * HALF, w); } }
    }
};
struct EpiGlu {
    static constexpr bool PERM = false;
    const float* X; float* H;
    __device__ __forceinline__ void operator()(const Acc& acc, const Unit& u, int, int wr, int wc, int fr, int fq) const {
        const int row0 = u.pm * BM + wr * 64 + fr, col0 = u.pn * HALF + wc * 32 + 4 * fq;
#pragma unroll
        for (int ai = 0; ai < 2; ++ai)
#pragma unroll
            for (int m = 0; m < 4; ++m) { const size_t off = (size_t)(row0 + ai * HALF + m * 16) * DM + col0;
#pragma unroll
                for (int n = 0; n < 2; ++n) { const f32x4 a = acc[ai][0][m][n], b = acc[ai][1][m][n]; const f32x4 xv = *(const f32x4*)(X + off + n * 16);
                    f32x4 o; o[0] = xv[0] + a[0] * fast_sigmoid(b[0]); o[1] = xv[1] + a[1] * fast_sigmoid(b[1]); o[2] = xv[2] + a[2] * fast_sigmoid(b[2]); o[3] = xv[3] + a[3] * fast_sigmoid(b[3]);
                    st16_wt(H + off + n * 16, o); } }
    }
};
struct EpiGateUp {
    static constexpr bool PERM = true;
    bf16_t* Hm; const LAS float* tabR; const LAS float* tabW;
    __device__ __forceinline__ void operator()(const Acc& acc, const Unit& u, int ui, int wr, int wc, int fr, int fq) const {
        const int col0 = u.pn * HALF + wc * 32 + 8 * fq;
#pragma unroll
        for (int ai = 0; ai < 2; ++ai)
#pragma unroll
            for (int m = 0; m < 4; ++m) { const int rl = ai * HALF + wr * 64 + m * 16 + fr; const float r = tabR[ui * 256 + rl], w = tabW[ui * 256 + rl];
                float hv[8];
#pragma unroll
                for (int n = 0; n < 2; ++n)
#pragma unroll
                    for (int j = 0; j < 4; ++j) { const float g = acc[ai][0][m][n][j] * r, up = acc[ai][1][m][n][j] * r; hv[n * 4 + j] = g * fast_sigmoid(g) * up * w; }
                u32x4 o; o.x = cvt_pk_bf16(hv[0], hv[1]); o.y = cvt_pk_bf16(hv[2], hv[3]); o.z = cvt_pk_bf16(hv[4], hv[5]); o.w = cvt_pk_bf16(hv[6], hv[7]);
                st16_wt(Hm + (size_t)(u.pm * BM + rl) * FF + col0, o); }
    }
};
struct EpiDown {
    static constexpr bool PERM = true;
    bf16_t* Y; const LAS unsigned* tabD;
    __device__ __forceinline__ void operator()(const Acc& acc, const Unit& u, int ui, int wr, int wc, int fr, int fq) const {
        const int col0 = u.pn * BM + wc * 32 + 8 * fq;
#pragma unroll
        for (int ai = 0; ai < 2; ++ai)
#pragma unroll
            for (int m = 0; m < 4; ++m) { const int rl = ai * HALF + wr * 64 + m * 16 + fr; const unsigned d = tabD[ui * 256 + rl];
                if (d != 0xFFFFFFFFu) { bf16_t* rowp = Y + (size_t)d * DM + col0;
#pragma unroll
                    for (int bj = 0; bj < 2; ++bj) { const f32x4 v0 = acc[ai][bj][m][0], v1 = acc[ai][bj][m][1];
                        u32x4 w; w.x = cvt_pk_bf16(v0[0], v0[1]); w.y = cvt_pk_bf16(v0[2], v0[3]); w.z = cvt_pk_bf16(v1[0], v1[1]); w.w = cvt_pk_bf16(v1[2], v1[3]);
                        st16_wt(rowp + bj * HALF, w); } } }
    }
};
struct EpiResAdd {
    static constexpr bool PERM = false;
    float* H;
    __device__ __forceinline__ void operator()(const Acc& acc, const Unit& u, int, int wr, int wc, int fr, int fq) const {
        const int row0 = u.pm * BM + wr * 64 + fr, col0 = u.pn * BM + wc * 32 + 4 * fq;
#pragma unroll
        for (int ai = 0; ai < 2; ++ai)
#pragma unroll
            for (int m = 0; m < 4; ++m) { float* rowp = H + (size_t)(row0 + ai * HALF + m * 16) * DM + col0;
#pragma unroll
                for (int bj = 0; bj < 2; ++bj)
#pragma unroll
                    for (int n = 0; n < 2; ++n) { f32x4* p = (f32x4*)(rowp + bj * HALF + n * 16); const f32x4 t = *p + acc[ai][bj][m][n]; st16_wt(p, t); } }
    }
};
}

struct Args { const float* in[32]; float* out; unsigned char* ws; int ph_lo, ph_hi; int dbg_kind, dbg_pad; size_t dbg_off; };
typedef const __attribute__((address_space(4))) Args* KArgsPtr;
struct Frame {
    LAS unsigned char* lds; unsigned* ctl;
    int tid, lane, wave, vcu, G, bid;
    unsigned char* ws;
};
__device__ __forceinline__ KArgsPtr launder_args(KArgsPtr kp) { asm volatile("" : "+s"(kp)); return kp; }
__device__ __forceinline__ Frame make_frame(KArgsPtr a, LAS unsigned char* lds) {
    Frame F; { unsigned lb = (unsigned)(uintptr_t)lds; asm volatile("" : "+s"(lb)); F.lds = (LAS unsigned char*)(uintptr_t)lb; } F.tid = tid_opaque(); F.lane = F.tid & 63; F.wave = __builtin_amdgcn_readfirstlane(F.tid >> 6);
    F.G = grid_opaque(); F.bid = bid_opaque(); { const int bx = F.bid; F.vcu = (F.G % 8 == 0) ? (bx % 8) * (F.G / 8) + bx / 8 : bx; }
    F.ws = a->ws; F.ctl = (unsigned*)(F.ws + WS_CTL);
    return F;
}

__device__ __forceinline__ void conv_tile(const float* __restrict__ W, int N, int k0, int n0, const float* __restrict__ gain, int gmask, float gscale,
                                          bf16_t* __restrict__ dst, int ldk, int drow0, LAS unsigned* scr, int lane) {
    const int kk = lane >> 4, nq = lane & 15;
    f32x4 v[16];
#pragma unroll
    for (int i = 0; i < 16; ++i) v[i] = *(const f32x4*)(W + (size_t)(k0 + 2 * kk + (i & 1) + 8 * (i >> 1)) * N + n0 + 4 * nq);
#pragma unroll
    for (int ip = 0; ip < 8; ++ip) {
        const int k = k0 + 2 * kk + 8 * ip;
        const float g0 = gain ? gain[k & gmask] * gscale : 1.0f, g1 = gain ? gain[(k + 1) & gmask] * gscale : 1.0f;
#pragma unroll
        for (int j = 0; j < 4; ++j) { const int n = 4 * nq + j; scr[n * 32 + ((kk + 4 * ip) ^ (nq << 1))] = cvt_pk_bf16(v[2 * ip][j] * g0, v[2 * ip + 1][j] * g1); }
    }
    LDS_WAIT();
#pragma unroll
    for (int jj = 0; jj < 8; ++jj) {
        const int n = (lane >> 3) + 8 * jj, c = lane & 7;
        u32x4 w = *(const LAS u32x4*)(scr + n * 32 + 4 * (c ^ jj));
        if ((n >> 2) & 1) w = (u32x4){w.z, w.w, w.x, w.y};
        st16_wt(dst + (size_t)(drow0 + n) * ldk + k0 + 8 * c, w);
    }
    LDS_WAIT();
}
__device__ __forceinline__ int ileave(int n0) { return (n0 >> 7) * 256 + (n0 & 127); }

__device__ __forceinline__ void p0_prologue(Frame& F, KArgsPtr a) {
    LAS unsigned* scr = (LAS unsigned*)(F.lds + F.wave * 8192);
    const int gw = F.vcu * NWAVES + F.wave, NGW = F.G * NWAVES, lane = F.lane;
    unsigned char* ws = F.ws;
    constexpr int T_WIN = 64 * 32, T_GL = 32 * 64, T_SQ = 64 * 64, T_EXP = 3 * 1024;
    constexpr int O_GLA = T_WIN, O_GLB = O_GLA + T_GL, O_Q = O_GLB + T_GL, O_K = O_Q + T_SQ, O_V = O_K + T_SQ, O_O = O_V + T_SQ, O_MOE = O_O + T_SQ, NT_ALL = O_MOE + 32 * T_EXP;
    for (int it = gw; it < NT_ALL; it += NGW) {
        if (it < O_GLA) { const int r = it, kb = r / 32, nb = r % 32;
            conv_tile(a->in[1], SW, kb * 64, nb * 64, a->in[29], -1, 1.f, (bf16_t*)(ws + WS_WIN), DM, nb * 64, scr, lane); }
        else if (it < O_Q) { const int half = it >= O_GLB; const int r = it - (half ? O_GLB : O_GLA), kb = r / 64, nb = r % 64;
            conv_tile(half ? a->in[11] : a->in[10], DM, kb * 64, nb * 64, nullptr, -1, 1.f, (bf16_t*)(ws + WS_GLU), SW, ileave(nb * 64) + half * 128, scr, lane); }
        else if (it < O_O) { const int which = (it - O_Q) / T_SQ; const int r = (it - O_Q) % T_SQ, kb = r / 64, nb = r % 64;
            const float* W = which == 0 ? a->in[15] : (which == 1 ? a->in[13] : a->in[14]); const float* g = which == 0 ? a->in[29] + DM : a->in[12];
            conv_tile(W, AW, kb * 64, nb * 64, g, -1, 1.f, (bf16_t*)(ws + WS_QKV), DM, which * AW + nb * 64, scr, lane); }
        else if (it < O_MOE) { const int r = it - O_O, kb = r / 64, nb = r % 64;
            conv_tile(a->in[21], DM, kb * 64, nb * 64, a->in[20], 255, 1.0f - LAMBDA_INIT1, (bf16_t*)(ws + WS_WO), AW, nb * 64, scr, lane); }
        else { const int r0 = it - O_MOE, le = r0 / T_EXP, r1 = r0 % T_EXP, which = r1 / 1024, r = r1 % 1024, li = le / NE;
            if (which < 2) { const int kb = r / 16, nb = r % 16;
                conv_tile((which ? a->in[27] : a->in[26]) + (size_t)le * DM * FF, FF, kb * 64, nb * 64, a->in[30] + li * DM, -1, 1.f,
                          (bf16_t*)(ws + WS_GU) + (size_t)le * 2048 * DM, DM, ileave(nb * 64) + which * 128, scr, lane); }
            else { const int kb = r / 64, nb = r % 64;
                conv_tile(a->in[28] + (size_t)le * FF * DM, DM, kb * 64, nb * 64, nullptr, -1, 1.f, (bf16_t*)(ws + WS_DN) + (size_t)le * DM * FF, FF, nb * 64, scr, lane); } }
    }
    { float* WrT = (float*)(ws + WS_WRT);
      for (int i = (F.vcu * NWAVES + F.wave) * 64 + lane; i < 2 * 32 * DM; i += NGW * 64) { const int li = i / (32 * DM), c = (i / DM) % 32, k = i % DM; const float g = a->in[30][li * DM + k];
          float v = 0.f; if (c < 4) v = a->in[22][((size_t)li * DM + k) * 4 + c] * g; else if (c < 20) v = a->in[24][((size_t)li * DM + k) * 16 + (c - 4)] * g;
          st4_wt(WrT + i, __builtin_bit_cast(unsigned, v)); } }
    { const float* x = a->in[0]; bf16_t* xb = (bf16_t*)(ws + WS_XB); float* rstd = (float*)(ws + WS_RSTD);
      for (int m = gw; m < T; m += NGW) { const f32x4* xr = (const f32x4*)(x + (size_t)m * DM) + lane; u32x2* o8 = (u32x2*)(xb + (size_t)m * DM) + lane; float s = 0.f;
#pragma unroll
          for (int j = 0; j < 16; ++j) { const f32x4 v = xr[64 * j]; s += (v.x * v.x + v.y * v.y) + (v.z * v.z + v.w * v.w); st8_wt(o8 + 64 * j, (u32x2){cvt_pk_bf16(v.x, v.y), cvt_pk_bf16(v.z, v.w)}); }
          s = wave_sum(s); if (lane == 0) st_coh(rstd + m, 1.0f / sqrtf(s * (1.0f / DM) + EPS)); } }
}

template <bool COMBINE, bool ROUTER>
__device__ __forceinline__ void rn_phase(Frame& F, float* H, const bf16_t* Y, bf16_t* hb, float* rstd, const float* WrT, const float* bgroup, const float* brouter,
                                         unsigned* cnt, int* list_tok, float* list_w) {
    LAS float* pss = (LAS float*)(F.lds);
    LAS float* plg = (LAS float*)(F.lds + 1024);
    const int lane = F.lane, r = lane & 15, kq = lane >> 4, wave = F.wave;
    for (int task = F.vcu; task < T / 16; task += F.G) {
        const int row = task * 16 + r; const size_t rb = (size_t)row * DM + wave * 512 + 4 * kq;
        f32x4 acc0 = {0.f, 0.f, 0.f, 0.f}, acc1 = {0.f, 0.f, 0.f, 0.f}; float ss = 0.f;
        const float* w0p = WrT + (size_t)r * DM + wave * 512 + 4 * kq; const float* w1p = w0p + (size_t)16 * DM;
#pragma unroll 8
        for (int s = 0; s < 32; ++s) {
            f32x4 v = *(const f32x4*)(H + rb + 16 * s);
            if constexpr (COMBINE) { const u32x2 ya = *(const u32x2*)(Y + rb + 16 * s), yb2 = *(const u32x2*)(Y + (size_t)T * DM + rb + 16 * s);
                v.x += bf2f(ya.x & 0xffffu) + bf2f(yb2.x & 0xffffu); v.y += bf2f(ya.x >> 16) + bf2f(yb2.x >> 16); v.z += bf2f(ya.y & 0xffffu) + bf2f(yb2.y & 0xffffu); v.w += bf2f(ya.y >> 16) + bf2f(yb2.y >> 16);
                st16_wt(H + rb + 16 * s, v); }
            ss += (v.x * v.x + v.y * v.y) + (v.z * v.z + v.w * v.w);
            st8_wt(hb + rb + 16 * s, (u32x2){cvt_pk_bf16(v.x, v.y), cvt_pk_bf16(v.z, v.w)});
            if constexpr (ROUTER) { const f32x4 w0 = *(const f32x4*)(w0p + 16 * s), w1 = *(const f32x4*)(w1p + 16 * s);
#pragma unroll
                for (int j = 0; j < 4; ++j) { acc0 = __builtin_amdgcn_mfma_f32_16x16x4f32(v[j], w0[j], acc0, 0, 0, 0); acc1 = __builtin_amdgcn_mfma_f32_16x16x4f32(v[j], w1[j], acc1, 0, 0, 0); } }
        }
        ss += __shfl_xor(ss, 16); ss += __shfl_xor(ss, 32);
        if (kq == 0) pss[wave * 16 + r] = ss;
        if constexpr (ROUTER) {
#pragma unroll
            for (int q = 0; q < 4; ++q) { plg[(wave * 16 + 4 * kq + q) * 32 + r] = acc0[q]; plg[(wave * 16 + 4 * kq + q) * 32 + 16 + r] = acc1[q]; } }
        __syncthreads();
        if (F.tid < 16) { const int t = F.tid, tok = task * 16 + t; float s = 0.f;
#pragma unroll
            for (int w = 0; w < 8; ++w) s += pss[w * 16 + t];
            const float rs = 1.0f / sqrtf(s * (1.0f / DM) + EPS); st_coh(rstd + tok, rs);
            if constexpr (ROUTER) {
                float lg[4];
#pragma unroll
                for (int c = 0; c < 4; ++c) { float q = 0.f;
#pragma unroll
                    for (int w = 0; w < 8; ++w) q += plg[(w * 16 + t) * 32 + c];
                    lg[c] = q * rs + bgroup[c]; }
                int gi = 0; float gm = lg[0];
#pragma unroll
                for (int c = 1; c < 4; ++c) if (lg[c] > gm) { gm = lg[c]; gi = c; }
                float den = 0.f;
#pragma unroll
                for (int c = 0; c < 4; ++c) den += expf(lg[c] - gm);
                const float gval = 1.0f / den;
                float sv[4];
#pragma unroll
                for (int j = 0; j < 4; ++j) { float q = 0.f;
#pragma unroll
                    for (int w = 0; w < 8; ++w) q += plg[(w * 16 + t) * 32 + 4 + 4 * gi + j];
                    sv[j] = q * rs + brouter[4 * gi + j]; }
                int i1 = 0; float v1 = sv[0];
#pragma unroll
                for (int j = 1; j < 4; ++j) if (sv[j] > v1) { v1 = sv[j]; i1 = j; }
                int i2 = -1; float v2 = -3.0e38f;
#pragma unroll
                for (int j = 0; j < 4; ++j) if (j != i1 && sv[j] > v2) { v2 = sv[j]; i2 = j; }
                const float w1 = 1.0f / (1.0f + expf(v2 - v1)), w2 = 1.0f - w1;
                const int e1 = 4 * gi + i1, e2 = 4 * gi + i2;
#ifdef DBG_ROUTE
                { float* dbg = (float*)(F.ws + WS_OB) + (size_t)tok * 4096; for (int q = 0; q < 4096; q += 4) { dbg[q] = (float)e1; dbg[q + 1] = (float)e2; dbg[q + 2] = w1 * gval; dbg[q + 3] = rs; } }
#endif
                const unsigned p1 = __hip_atomic_fetch_add(cnt + e1 * 64, 1u, __ATOMIC_RELAXED, __HIP_MEMORY_SCOPE_AGENT);
                const unsigned p2 = __hip_atomic_fetch_add(cnt + e2 * 64, 1u, __ATOMIC_RELAXED, __HIP_MEMORY_SCOPE_AGENT);
                if (p1 < (unsigned)LISTCAP) { st_coh(list_tok + e1 * LISTCAP + p1, tok * 2); st_coh(list_w + e1 * LISTCAP + p1, w1 * gval); }
                if (p2 < (unsigned)LISTCAP) { st_coh(list_tok + e2 * LISTCAP + p2, tok * 2 + 1); st_coh(list_w + e2 * LISTCAP + p2, w2 * gval); }
            }
        }
        __syncthreads();
    }
}

template <bool DOWN>
__device__ __forceinline__ int build_group(Frame& F, const unsigned* cnt, const int* list_tok, const float* list_w, const float* rstd, int nN, int K2  ) {
    LAS int* ti = (LAS int*)(F.lds + TAB_OFF);
    LAS unsigned* tabA = (LAS unsigned*)(F.lds + TAB_OFF + 256);
    LAS float* tabR = (LAS float*)(F.lds + TAB_OFF + 256 + 8 * 1024);
    LAS float* tabW = (LAS float*)(F.lds + TAB_OFF + 256 + 16 * 1024);
    if (F.tid == 0) {
        int ts = 0;
        for (int e = 0; e < NE; ++e) { ti[8 + e] = ts; const unsigned c = __hip_atomic_load(cnt + e * 64, __ATOMIC_RELAXED, __HIP_MEMORY_SCOPE_AGENT); ts += (int)((c > (unsigned)LISTCAP ? (unsigned)LISTCAP : c) + 255u) >> 8; }
        ti[8 + NE] = ts;
        int n = 0;
        for (int i = 0; n < 8; ++i) { const long L = (long)i * F.G + F.bid; if (L >= (long)ts * nN) break; int pm, pn; pg8::tile_of((int)L, ts, nN, pm, pn);
            int e = 0; while (e < NE - 1 && ti[8 + e + 1] <= pm) ++e;
            ti[32 + 3 * n] = pm; ti[32 + 3 * n + 1] = pn; ti[32 + 3 * n + 2] = e * nN + pn; ++n; }
        ti[0] = n;
    }
    __syncthreads();
    const int n = ti[0];
    for (int i = 0; i < n; ++i) {
        if (F.tid < 256) { const int rr = F.tid, pm = ti[32 + 3 * i], e = ti[32 + 3 * i + 2] / nN, idx = (pm - ti[8 + e]) * 256 + rr;
            unsigned c = __hip_atomic_load(cnt + e * 64, __ATOMIC_RELAXED, __HIP_MEMORY_SCOPE_AGENT); if (c > (unsigned)LISTCAP) c = LISTCAP;
            const bool valid = (unsigned)idx < c;
            int tk = 0; float w = 0.f; if (valid) { tk = ld_coh(list_tok + e * LISTCAP + idx); w = ld_coh(list_w + e * LISTCAP + idx); }
            if constexpr (DOWN) { tabA[i * 256 + rr] = valid ? (unsigned)((tk & 1) * T + (tk >> 1)) : 0xFFFFFFFFu; }
            else { tabA[i * 256 + rr] = (unsigned)(tk >> 1) * (unsigned)K2; tabR[i * 256 + rr] = valid ? ld_coh(rstd + (tk >> 1)) : 0.f; tabW[i * 256 + rr] = w; } }
    }
    __syncthreads();
    return n;
}

__device__ __forceinline__ float gelu_tanh(float y) { const float z = 1.5957691216f * (y + 0.044715f * y * y * y); return y * fast_sigmoid(z); }
struct Cx { float re, im; };
__device__ __forceinline__ Cx cmul(Cx a, Cx b) { return {a.re * b.re - a.im * b.im, a.re * b.im + a.im * b.re}; }
__device__ __forceinline__ Cx cfma(Cx a, Cx b, Cx c) { return {fmaf(a.re, b.re, fmaf(-a.im, b.im, c.re)), fmaf(a.re, b.im, fmaf(a.im, b.re, c.im))}; }
template <int PASS>
__device__ __forceinline__ void scan_task(KArgsPtr a, unsigned char* ws, LAS unsigned char* wlds, int b, int g, int seg, int lane) {
    const int c = lane & 31, hi = lane >> 5; int chkflag = 0; (void)chkflag;
    const bf16_t* ub = (const bf16_t*)(ws + WS_UB); bf16_t* yb = (bf16_t*)(ws + WS_YB); float* ends = (float*)(ws + WS_ENDS);
    const float dt = expf(a->in[4][g]);
    Cx lam[2], lam16[2]; bf16x8 Bre[2], Bim[2];
#pragma unroll
    for (int s = 0; s < 2; ++s) { const int p = c + 32 * s; const float are = a->in[2][g * SP + p], aim = a->in[3][g * SP + p];
        const float mag = expf(are * dt), th = aim * dt; const float lr = mag * __cosf(th), li = mag * __sinf(th);
        lam[s] = {lr, li};
        const float den = are * are + aim * aim, nr = lr - 1.0f; const float qre = (nr * are + li * aim) / den, qim = (li * are - nr * aim) / den;
        const float* brp = a->in[5] + ((size_t)(g * SP + p)) * SJ + 8 * hi; const float* bip = a->in[6] + ((size_t)(g * SP + p)) * SJ + 8 * hi;
        const f32x4 br0 = *(const f32x4*)brp, br1 = *(const f32x4*)(brp + 4), bi0 = *(const f32x4*)bip, bi1 = *(const f32x4*)(bip + 4);
        float vr[8], vi[8];
#pragma unroll
        for (int j = 0; j < 4; ++j) { vr[j] = qre * br0[j] - qim * bi0[j]; vi[j] = qre * bi0[j] + qim * br0[j]; vr[4 + j] = qre * br1[j] - qim * bi1[j]; vi[4 + j] = qre * bi1[j] + qim * br1[j]; }
        u32x4 wr_ = {cvt_pk_bf16(vr[0], vr[1]), cvt_pk_bf16(vr[2], vr[3]), cvt_pk_bf16(vr[4], vr[5]), cvt_pk_bf16(vr[6], vr[7])};
        u32x4 wi_ = {cvt_pk_bf16(vi[0], vi[1]), cvt_pk_bf16(vi[2], vi[3]), cvt_pk_bf16(vi[4], vi[5]), cvt_pk_bf16(vi[6], vi[7])};
        Bre[s] = __builtin_bit_cast(bf16x8, wr_); Bim[s] = __builtin_bit_cast(bf16x8, wi_);
        Cx l2 = cmul(lam[s], lam[s]), l4 = cmul(l2, l2), l8 = cmul(l4, l4); lam16[s] = cmul(l8, l8); }
    Cx carry[2] = {{0.f, 0.f}, {0.f, 0.f}};
    bf16x8 Cf[4]; float dsk = 0.f;
    if constexpr (PASS == 2) {
        Cx lamL[2];
#pragma unroll
        for (int s = 0; s < 2; ++s) { Cx t = lam16[s]; for (int q = 16; q < LSEG; q <<= 1) t = cmul(t, t); lamL[s] = t; }
        for (int sp = 0; sp < seg; ++sp) {
#pragma unroll
            for (int s = 0; s < 2; ++s) { const float* ep = ends + ((size_t)((b * NG + g) * NSEG + sp)) * 128 + 2 * (c + 32 * s); carry[s] = cfma(lamL[s], carry[s], Cx{ld_coh(ep), ld_coh(ep + 1)}); } }
#ifdef DBG_SELFCHK2
        { Cx c2[2] = {{0.f, 0.f}, {0.f, 0.f}};
          for (int sp = 0; sp < seg; ++sp) {
#pragma unroll
            for (int s = 0; s < 2; ++s) { const float* ep = ends + ((size_t)((b * NG + g) * NSEG + sp)) * 128 + 2 * (c + 32 * s); c2[s] = cfma(lamL[s], c2[s], Cx{ld_coh(ep), ld_coh(ep + 1)}); } }
          _Pragma("unroll") for (int s = 0; s < 2; ++s) if (__builtin_bit_cast(unsigned, c2[s].re) != __builtin_bit_cast(unsigned, carry[s].re) || __builtin_bit_cast(unsigned, c2[s].im) != __builtin_bit_cast(unsigned, carry[s].im)) chkflag |= 2; }
#endif
        const int ca = lane & 15, kq = lane >> 4;
#pragma unroll
        for (int ks = 0; ks < 4; ++ks) { const f32x4 cr = *(const f32x4*)(a->in[7] + ((size_t)(g * SJ + ca)) * SP + 16 * ks + 4 * kq), ci = *(const f32x4*)(a->in[8] + ((size_t)(g * SJ + ca)) * SP + 16 * ks + 4 * kq);
            u32x4 w = {cvt_pk_bf16(cr[0], -ci[0]), cvt_pk_bf16(cr[1], -ci[1]), cvt_pk_bf16(cr[2], -ci[2]), cvt_pk_bf16(cr[3], -ci[3])}; Cf[ks] = __builtin_bit_cast(bf16x8, w); }
        dsk = a->in[9][g * SJ + ca];
    }
    const int tl = 16 * ((c >> 2) & 1) + (c & 3) + 4 * (c >> 3);
    LAS unsigned* Xs = (LAS unsigned*)wlds;
    for (int ch = 0; ch < LSEG / 32; ++ch) {
        const int t0 = b * SEQ + seg * LSEG + ch * 32;
        const bf16x8 af = *(const bf16x8*)(ub + (size_t)(t0 + tl) * SW + g * SJ + 8 * hi);
        f32x16 X[2][2];
#pragma unroll
        for (int s = 0; s < 2; ++s) { const f32x16 z = {};
            X[s][0] = __builtin_amdgcn_mfma_f32_32x32x16_bf16(af, Bre[s], z, 0, 0, 0); X[s][1] = __builtin_amdgcn_mfma_f32_32x32x16_bf16(af, Bim[s], z, 0, 0, 0); }
#pragma unroll
        for (int s = 0; s < 2; ++s) {
            Cx x = {0.f, 0.f};
#pragma unroll
            for (int r = 0; r < 16; ++r) { x = cfma(lam[s], x, Cx{X[s][0][r], X[s][1][r]}); X[s][0][r] = x.re; X[s][1][r] = x.im; }
            const Cx eo = {__shfl_xor(x.re, 32), __shfl_xor(x.im, 32)};
            if constexpr (PASS == 1) { const Cx e0 = hi ? eo : x, e1 = hi ? x : eo; carry[s] = cfma(lam16[s], cfma(lam16[s], carry[s], e0), e1); }
            else {
                const Cx cin1 = cfma(lam16[s], carry[s], eo); Cx w = hi ? cin1 : carry[s];
#pragma unroll
                for (int r = 0; r < 16; ++r) { w = cmul(lam[s], w); X[s][0][r] += w.re; X[s][1][r] += w.im; }
                const Cx fin = {X[s][0][15], X[s][1][15]}; const Cx fo = {__shfl_xor(fin.re, 32), __shfl_xor(fin.im, 32)};
                carry[s] = hi ? fin : fo;
#pragma unroll
                for (int r = 0; r < 16; ++r) Xs[(16 * hi + r) * 68 + c + 32 * s] = cvt_pk_bf16(X[s][0][r], X[s][1][r]);
            }
        }
        if constexpr (PASS == 2) {
            LDS_WAIT();
            const int ca = lane & 15, kq = lane >> 4;
#pragma unroll
            for (int rb = 0; rb < 2; ++rb) { f32x4 acc = {0.f, 0.f, 0.f, 0.f}; asm volatile("" : "+v"(acc));
#pragma unroll
                for (int ks = 0; ks < 4; ++ks) { const bf16x8 xf = *(const LAS bf16x8*)(Xs + (16 * rb + ca) * 68 + 16 * ks + 4 * kq); acc = __builtin_amdgcn_mfma_f32_16x16x32_bf16(xf, Cf[ks], acc, 0, 0, 0); }
#ifdef DBG_SELFCHK
                { f32x4 acc2 = {0.f, 0.f, 0.f, 0.f}; asm volatile("" : "+v"(acc2)); LDS_WAIT();
#pragma unroll
                  for (int ks = 0; ks < 4; ++ks) { const bf16x8 xf = *(const LAS bf16x8*)(Xs + (16 * rb + ca) * 68 + 16 * ks + 4 * kq); acc2 = __builtin_amdgcn_mfma_f32_16x16x32_bf16(xf, Cf[ks], acc2, 0, 0, 0); }
                  if (__builtin_bit_cast(unsigned, acc[0]) != __builtin_bit_cast(unsigned, acc2[0]) || __builtin_bit_cast(unsigned, acc[1]) != __builtin_bit_cast(unsigned, acc2[1]) ||
                      __builtin_bit_cast(unsigned, acc[2]) != __builtin_bit_cast(unsigned, acc2[2]) || __builtin_bit_cast(unsigned, acc[3]) != __builtin_bit_cast(unsigned, acc2[3])) chkflag |= 1; }
#endif
#pragma unroll
                for (int q = 0; q < 4; ++q) { const size_t o = (size_t)(t0 + 16 * rb + 4 * kq + q) * SW + g * SJ + ca; const float y = acc[q] + dsk * bf2f(ub[o]); st2_wt(yb + o, f2bf(gelu_tanh(y))); } }
            LDS_WAIT();
        }
    }
#if defined(DBG_SELFCHK) || defined(DBG_SELFCHK2) || defined(DBG_SELFCHK3)
    if constexpr (PASS == 2) { const int any = __any(chkflag != 0); float* dbg = (float*)(ws + WS_OC); if (lane == 0) dbg[(b * NG + g) * NSEG + seg] = any ? 1000.f : 0.f; }
#endif
    if constexpr (PASS == 1) { if (hi == 0) {
#pragma unroll
        for (int s = 0; s < 2; ++s) st8_wt(ends + ((size_t)((b * NG + g) * NSEG + seg)) * 128 + 2 * (c + 32 * s), (u32x2){__builtin_bit_cast(unsigned, carry[s].re), __builtin_bit_cast(unsigned, carry[s].im)}); } }
}
template <int PASS>
__device__ __forceinline__ void scan_phase(Frame& F, KArgsPtr a) {
    const int gw = F.vcu * NWAVES + F.wave, NGW = F.G * NWAVES;
    for (int task = gw; task < BATCH * NG * NSEG; task += NGW) { const int seg = task % NSEG, g = (task / NSEG) % NG, b = task / (NSEG * NG);
        if (PASS == 1 && seg == NSEG - 1) continue;
        scan_task<PASS>(a, F.ws, F.lds + F.wave * 9216, b, g, seg, F.lane); }
}

namespace att {
constexpr int D = 128, PITCH = 4096;
constexpr float SCALE = 0.08838834764831845f;
constexpr float THR = 8.f;
constexpr int NW = 8, QBLK = 32, KVBLK = 64, QB = NW * QBLK;
constexpr int SHM_V = KVBLK * D * 2, SHM_K = KVBLK * D * 2;
constexpr int ATT_LDS = 2 * SHM_V + 2 * SHM_K + NW * 64 * 4;
#define KSWZ(row, colB) ((row) * 256 + ((colB) ^ (((row) & 7) << 4)))
#define SBAR() __builtin_amdgcn_sched_barrier(0)
__device__ __forceinline__ int v_st(int k, int c) { const int kk = (k & ~0xC) | ((k & 4) << 1) | ((k & 8) >> 1); return ((kk >> 3) * 4 + (c >> 5)) * 512 + ((kk & 7) * 32 + (c & 31)) * 2; }
__device__ __forceinline__ int v_rd_base(int lane) { return ((lane & 3) << 3) | (((lane >> 2) & 3) << 6) | (((lane >> 4) & 1) << 5) | (((lane >> 5) & 1) << 8); }
constexpr int v_rd_off(int d0, int ks, int half) { return d0 * 512 + ks * 4096 + half * 2048; }
__device__ __forceinline__ int crow(int r, int hi) { return (r & 3) + 8 * (r >> 2) + 4 * hi; }
__device__ __forceinline__ unsigned cvtpk(float lo, float hi) { unsigned r; asm volatile("v_cvt_pk_bf16_f32 %0, %1, %2" : "=v"(r) : "v"(lo), "v"(hi)); return r; }
__device__ __forceinline__ bf16x8 load8(const bf16_t* p) { return *reinterpret_cast<const bf16x8*>(p); }
__device__ __forceinline__ void mask_tile(f32x16& p0, f32x16& p1, int dq, unsigned W) {
    const float NEG = -__builtin_inff();
#pragma unroll
    for (int r = 0; r < 16; ++r) { const int c = (r & 3) + 8 * (r >> 2);
        if ((unsigned)(dq - c) >= W) p0[r] = NEG;
        if ((unsigned)(dq - c - 32) >= W) p1[r] = NEG; }
}
__device__ __forceinline__ void partialSM(f32x16& p0, f32x16& p1, float& m_reg, float& mn, float& alpha) {
    float pmax = p0[0]; for (int r = 1; r < 16; ++r) pmax = fmaxf(pmax, p0[r]); for (int r = 0; r < 16; ++r) pmax = fmaxf(pmax, p1[r]);
    { auto rr = __builtin_amdgcn_permlane32_swap(__float_as_uint(pmax), __float_as_uint(pmax), false, false);
      pmax = fmaxf(__uint_as_float(rr[0]), __uint_as_float(rr[1])); }
    constexpr float C2 = 1.4426950408889634f * SCALE;
    if (__builtin_expect(__all((pmax - m_reg) * SCALE <= THR), 1)) { mn = m_reg; alpha = 1.f; }
    else { mn = fmaxf(m_reg, pmax); alpha = __builtin_amdgcn_exp2f((m_reg - mn) * C2); m_reg = mn; }
    const float mnL = -mn * C2;
    for (int r = 0; r < 16; ++r) p0[r] = fmaf(p0[r], C2, mnL); for (int r = 0; r < 16; ++r) p1[r] = fmaf(p1[r], C2, mnL);
    for (int r = 0; r < 16; ++r) p0[r] = __builtin_amdgcn_exp2f(p0[r]);
}
__device__ __forceinline__ void finishSM(f32x16& p0, f32x16& p1, float alpha, float& l_reg, bf16x8& pa0, bf16x8& pa1, bf16x8& pa2, bf16x8& pa3) {
    for (int r = 0; r < 16; ++r) p1[r] = __builtin_amdgcn_exp2f(p1[r]);
    float ps = 0; for (int r = 0; r < 16; ++r) ps += p0[r]; for (int r = 0; r < 16; ++r) ps += p1[r];
    { auto rr = __builtin_amdgcn_permlane32_swap(__float_as_uint(ps), __float_as_uint(ps), false, false);
      ps = __uint_as_float(rr[0]) + __uint_as_float(rr[1]); }
    l_reg = l_reg * alpha + ps;
#define PK4(P, B_, OUT) do { unsigned a0 = cvtpk(P[B_+0], P[B_+1]), a1 = cvtpk(P[B_+2], P[B_+3]);                          \
        unsigned b0 = cvtpk(P[B_+4], P[B_+5]), b1 = cvtpk(P[B_+6], P[B_+7]);                                             \
        auto r0 = __builtin_amdgcn_permlane32_swap(a0, b0, false, false); auto r1 = __builtin_amdgcn_permlane32_swap(a1, b1, false, false); \
        u32x4 w = {r0[0], r1[0], r0[1], r1[1]}; OUT = *reinterpret_cast<bf16x8*>(&w); } while (0)
    PK4(p0, 0, pa0); PK4(p0, 8, pa1); PK4(p1, 0, pa2); PK4(p1, 8, pa3);
#undef PK4
}
template <int KB>
__device__ __forceinline__ void qkt(f32x16& p0, f32x16& p1, const char* K_lds, int r32, int hi, const bf16x8* qr, float sl, float tb) {
    { const float sl8 = 8.0f * sl, sl32 = 32.0f * sl;
#pragma unroll
      for (int r = 0; r < 16; ++r) { p0[r] = (r == 0) ? tb : ((r & 3) ? p0[r - 1] + sl : p0[r - 4] + sl8); }
#pragma unroll
      for (int r = 0; r < 16; ++r) p1[r] = p0[r] + sl32; }
    const char* kb[4];
#pragma unroll
    for (int dd = 0; dd < 4; ++dd) kb[dd] = K_lds + KB * SHM_K + KSWZ(r32, (dd * 16 + hi * 8) * 2);
#pragma unroll
    for (int d0 = 0; d0 < 8; ++d0) { const char* a = kb[d0 & 3] + (d0 >> 2) * 128;
        bf16x8 b0 = *reinterpret_cast<const bf16x8*>(a);
        bf16x8 b1 = *reinterpret_cast<const bf16x8*>(a + 32 * 256);
        p0 = __builtin_amdgcn_mfma_f32_32x32x16_bf16(b0, qr[d0], p0, 0, 0, 0);
        p1 = __builtin_amdgcn_mfma_f32_32x32x16_bf16(b1, qr[d0], p1, 0, 0, 0); }
}
template <int VB>
__device__ __forceinline__ void pv_tile(f32x16* o, int vb0, bf16x8 pa0, bf16x8 pa1, bf16x8 pa2, bf16x8 pa3) {
#define TRRD(dst, off) asm volatile("ds_read_b64_tr_b16 %0, %1 offset:%2" : "=&v"(dst) : "v"(vb0), "i"(off) : "memory")
#define PV_D0(d0) do { s16x4 l0, l1, l2, l3, h0, h1, h2, h3; constexpr int b_ = VB * SHM_V + v_rd_off(d0, 0, 0);  \
        TRRD(l0, b_); TRRD(h0, b_ + 2048); TRRD(l1, b_ + 4096); TRRD(h1, b_ + 6144); TRRD(l2, b_ + 8192); TRRD(h2, b_ + 10240); TRRD(l3, b_ + 12288); TRRD(h3, b_ + 14336); \
        asm volatile("s_waitcnt lgkmcnt(0)" ::: "memory"); SBAR();   \
        o[d0] = __builtin_amdgcn_mfma_f32_32x32x16_bf16(pa0, (bf16x8){l0[0], l0[1], l0[2], l0[3], h0[0], h0[1], h0[2], h0[3]}, o[d0], 0, 0, 0);   \
        o[d0] = __builtin_amdgcn_mfma_f32_32x32x16_bf16(pa1, (bf16x8){l1[0], l1[1], l1[2], l1[3], h1[0], h1[1], h1[2], h1[3]}, o[d0], 0, 0, 0);   \
        o[d0] = __builtin_amdgcn_mfma_f32_32x32x16_bf16(pa2, (bf16x8){l2[0], l2[1], l2[2], l2[3], h2[0], h2[1], h2[2], h2[3]}, o[d0], 0, 0, 0);   \
        o[d0] = __builtin_amdgcn_mfma_f32_32x32x16_bf16(pa3, (bf16x8){l3[0], l3[1], l3[2], l3[3], h3[0], h3[1], h3[2], h3[3]}, o[d0], 0, 0, 0); } while (0)
    PV_D0(0); PV_D0(1); PV_D0(2); PV_D0(3);
#undef PV_D0
#undef TRRD
}
struct BlockRef { const bf16_t* Q; const bf16_t* K; const bf16_t* V; bf16_t* O; int P0; float sl; };
struct Seam { bf16x8 qr[8]; bf16x8 st_v0, st_v1, st_k0, st_k1; };
#define ROW(p, k0, rr) ((p) + (size_t)((k0) + (rr)) * PITCH + sc)
#define VMW() asm volatile("s_waitcnt vmcnt(0)" ::: "memory")
#define VMWN(n) asm volatile("s_waitcnt vmcnt(%0)" :: "i"(n) : "memory")
#define SLOAD_H(Kp, Vp, k0) do { S.st_v0 = load8(ROW(Vp, k0, sr)); S.st_v1 = load8(ROW(Vp, k0, 32 + sr));              \
                         S.st_k0 = load8(ROW(Kp, k0, sr)); S.st_k1 = load8(ROW(Kp, k0, 32 + sr)); } while (0)
#define SWRITE_HK(bf) do { *(bf16x8*)(K_lds + (bf) * SHM_K + kws) = S.st_k0; *(bf16x8*)(K_lds + (bf) * SHM_K + kws + 32 * 256) = S.st_k1; } while (0)
#define SWRITE_HV(bf) do { *(bf16x8*)(V_lds + (bf) * SHM_V + vst0) = S.st_v0; *(bf16x8*)(V_lds + (bf) * SHM_V + vst1) = S.st_v1; } while (0)
#define SWRITE_H(bf) do { SWRITE_HV(bf); SWRITE_HK(bf); } while (0)
__device__ __forceinline__ void causal_prime(const BlockRef& cur, char* lds, Seam& S) {
    const int tid = tid_opaque(), wid = __builtin_amdgcn_readfirstlane(tid >> 6), lane = tid & 63, r32 = lane & 31, hi = lane >> 5;
    const int sr = tid >> 4, sc = (tid & 15) * 8, kws = KSWZ(sr, sc * 2); char* K_lds = lds + 2 * SHM_V;
    for (int d0 = 0; d0 < 8; ++d0) S.qr[d0] = load8(cur.Q + (size_t)(wid * QBLK + r32) * PITCH + d0 * 16 + hi * 8);
    SLOAD_H(cur.K, cur.V, 0); VMW(); SWRITE_HK(0);
    __syncthreads();
}
__device__ __forceinline__ void causal_block(const BlockRef& cur, const BlockRef& nxt, char* lds, Seam& S) {
    const int tid = tid_opaque(), wid = __builtin_amdgcn_readfirstlane(tid >> 6), lane = tid & 63, r32 = lane & 31, hi = lane >> 5;
    const int W = SEQ;
    const int j_hi = (cur.P0 + QB - 1) / KVBLK + 1;
    const int NT = j_hi;
    const int qlo = cur.P0 + wid * QBLK, qm = qlo + r32 - 4 * hi;
    char* V_lds = lds; char* K_lds = lds + 2 * SHM_V;
    float* ws = (float*)(lds + 2 * SHM_V + 2 * SHM_K) + wid * 64; float* li_l = ws, * al_l = ws + 32;
    float m_reg = -1e30f, l_reg = 0; f32x16 o[4] = {};
    const int sr = tid >> 4, sc = (tid & 15) * 8, vst0 = v_st(sr, sc), vst1 = v_st(32 + sr, sc), kws = KSWZ(sr, sc * 2);
    const int vb0 = (int)(uintptr_t)V_lds + v_rd_base(lane);
    const bf16_t* Kh = cur.K; const bf16_t* Vh = cur.V;
    const float sl = cur.sl, tb0 = sl * (float)(4 * hi - cur.P0);
#define RESC(a) do { if (__any((a) < 1.f)) { if (hi == 0) al_l[r32] = (a); asm volatile("s_waitcnt lgkmcnt(0)" ::: "memory");              \
                     for (int d_ = 0; d_ < 4; ++d_) for (int r = 0; r < 16; ++r) o[d_][r] *= al_l[crow(r, hi)]; } } while (0)
#define KBASE(t) ((t) * KVBLK)
#define TB(t) fmaf(sl, (float)KBASE(t), tb0)
#define MASKT(P0_, P1_, t) do { const int kb_ = KBASE(t); if (kb_ + KVBLK - 1 > qlo) mask_tile(P0_, P1_, qm - kb_, (unsigned)W); } while (0)
    constexpr int NQL = 8;
#define SEAM_K0() do { VMWN(NQL); SWRITE_HK(0); SBAR(); } while (0)
    f32x16 pA0, pA1, pB0, pB1; float mnA, mnB, alA, alB; bf16x8 pa0, pa1, pa2, pa3;
    SWRITE_HV(0); SBAR();
    if (NT > 1) { SLOAD_H(Kh, Vh, KBASE(1)); }
    SBAR(); qkt<0>(pA0, pA1, K_lds, r32, hi, S.qr, sl, TB(0));
    MASKT(pA0, pA1, 0); partialSM(pA0, pA1, m_reg, mnA, alA);
    if (NT > 1) { VMW(); SWRITE_H(1); }
    __syncthreads();
#define HALF_STEP(PX0, PX1, mnX, alX, PY0, PY1, alY, t, KB, VB, SB) do {                                                      \
        SBAR(); qkt<KB>(PX0, PX1, K_lds, r32, hi, S.qr, sl, TB(t));                                             \
        finishSM(PY0, PY1, alY, l_reg, pa0, pa1, pa2, pa3); SBAR();                                                           \
        if ((t) + 1 < NT) { SLOAD_H(Kh, Vh, KBASE((t) + 1)); SBAR(); }                                               \
        pv_tile<VB>(o, vb0, pa0, pa1, pa2, pa3); MASKT(PX0, PX1, (t)); partialSM(PX0, PX1, m_reg, mnX, alX);                                        \
        __syncthreads();                                                                                                      \
        if ((t) + 1 < NT) { VMW(); SWRITE_H(SB); }                                                                          \
        RESC(alX); __syncthreads(); } while (0)
    for (int t = 1; t + 1 < NT; t += 2) {
        HALF_STEP(pB0, pB1, mnB, alB, pA0, pA1, alA, t, 1, 0, 0);
        HALF_STEP(pA0, pA1, mnA, alA, pB0, pB1, alB, t + 1, 0, 1, 1);
    }
    const bool even = (NT & 1) == 0;
    if (even) { SBAR(); qkt<1>(pB0, pB1, K_lds, r32, hi, S.qr, sl, TB(NT - 1)); SBAR(); }
    SLOAD_H(nxt.K, nxt.V, 0); SBAR();
#pragma unroll
    for (int d0 = 0; d0 < 8; ++d0) S.qr[d0] = load8(nxt.Q + (size_t)(wid * QBLK + r32) * PITCH + d0 * 16 + hi * 8);
    SBAR();
    finishSM(pA0, pA1, alA, l_reg, pa0, pa1, pa2, pa3); SBAR();
    pv_tile<0>(o, vb0, pa0, pa1, pa2, pa3);
    if (even) { MASKT(pB0, pB1, NT - 1); partialSM(pB0, pB1, m_reg, mnB, alB); __syncthreads(); RESC(alB);
        finishSM(pB0, pB1, alB, l_reg, pa0, pa1, pa2, pa3); SBAR(); pv_tile<1>(o, vb0, pa0, pa1, pa2, pa3); }
    SBAR(); SEAM_K0();
    if (hi == 0) li_l[r32] = l_reg; asm volatile("s_waitcnt lgkmcnt(0)" ::: "memory");
    float rli[16];
#pragma unroll
    for (int r = 0; r < 16; ++r) rli[r] = __builtin_amdgcn_rcpf(li_l[crow(r, hi)]);
    bf16_t* Ow = cur.O + (size_t)(wid * QBLK) * PITCH;
#pragma unroll
    for (int r = 0; r < 16; ++r) { const int orow = crow(r, hi);
#pragma unroll
        for (int d0 = 0; d0 < 4; ++d0) { const float v = o[d0][r] * rli[r];
            const float vn = __shfl_xor(v, 1);
            if ((r32 & 1) == 0) st4_wt(Ow + (size_t)orow * PITCH + d0 * 32 + r32, cvtpk(v, vn)); } }
    __syncthreads();
#undef RESC
#undef KBASE
#undef TB
#undef MASKT
#undef SEAM_K0
#undef HALF_STEP
}
#undef ROW
#undef VMW
#undef VMWN
#undef SLOAD_H
#undef SWRITE_HK
#undef SWRITE_HV
#undef SWRITE_H
#undef KSWZ
#undef SBAR
__device__ __forceinline__ BlockRef make_ref(unsigned char* ws, int hp, int qb) {
    const int vh = hp & 1, c = (hp >> 1) & 1, h = (hp >> 2) & 15, b = hp >> 6;
    const bf16_t* Q = (const bf16_t*)(ws + WS_Q); const bf16_t* Kp = Q + (size_t)T * AW; const bf16_t* Vp = Kp + (size_t)T * AW; bf16_t* O = (bf16_t*)(ws + WS_OC) + (size_t)c * T * AW;
    BlockRef r; const size_t tok0 = (size_t)b * SEQ;
    r.Q = Q + (tok0 + (size_t)qb * QB) * PITCH + h * 256 + c * 128; r.K = Kp + tok0 * PITCH + h * 256 + c * 128; r.V = Vp + tok0 * PITCH + h * 256 + vh * 128;
    r.O = O + (tok0 + (size_t)qb * QB) * PITCH + h * 256 + vh * 128; r.P0 = qb * QB;
    r.sl = exp2f(-0.5f * (float)(h + 1)) * (1.0f / SCALE);
    return r;
}
__device__ __forceinline__ void attn_phase(unsigned char* ws, char* lds, int G, int bid) {
    constexpr int NQB = SEQ / QB, NX = NQB / 2, TOTAL = NX * 128;
    int L = bid; if (L >= TOTAL) return;
    int pass = 0;
    BlockRef cur = make_ref(ws, L / NX, L % NX);
    Seam S;
    causal_prime(cur, lds, S);
    for (;;) {
        const bool more_pass = pass == 0, more_item = L + G < TOTAL, last = !more_pass && !more_item;
        int Ln = L, passn = pass + 1;
        if (!more_pass) { passn = 0; Ln = more_item ? L + G : L; }
        const int xq = Ln % NX; const BlockRef nxt = last ? cur : make_ref(ws, Ln / NX, passn ? NQB - 1 - xq : xq);
        causal_block(cur, nxt, lds, S);
        if (last) break;
        cur = nxt; pass = passn; L = Ln;
    }
}
}

__device__ __forceinline__ void diff_phase(Frame& F, KArgsPtr a) {
    const int lane = F.lane, gw = F.vcu * NWAVES + F.wave, NGW = F.G * NWAVES;
    float d1 = a->in[16][lane] * a->in[17][lane] + a->in[16][lane + 64] * a->in[17][lane + 64];
    float d2 = a->in[18][lane] * a->in[19][lane] + a->in[18][lane + 64] * a->in[19][lane + 64];
    const float lam = expf(wave_sum(d1)) - expf(wave_sum(d2)) + LAMBDA_INIT1;
    const bf16_t* O0 = (const bf16_t*)(F.ws + WS_OC); const bf16_t* O1 = O0 + (size_t)T * AW; bf16_t* ob = (bf16_t*)(F.ws + WS_OB);
    for (int m = gw; m < T; m += NGW) {
        const size_t base = (size_t)m * AW + 64 * lane; float v[64]; float ss = 0.f;
#pragma unroll
        for (int j = 0; j < 8; ++j) { const u32x4 x0 = *(const u32x4*)(O0 + base + 8 * j), x1 = *(const u32x4*)(O1 + base + 8 * j);
#pragma unroll
            for (int q = 0; q < 4; ++q) { const float lo = bf2f(x0[q] & 0xffffu) - lam * bf2f(x1[q] & 0xffffu), hi2 = bf2f(x0[q] >> 16) - lam * bf2f(x1[q] >> 16);
                v[8 * j + 2 * q] = lo; v[8 * j + 2 * q + 1] = hi2; ss += lo * lo + hi2 * hi2; } }
        ss += __shfl_xor(ss, 1); ss += __shfl_xor(ss, 2);
        const float rs = 1.0f / sqrtf(ss * (1.0f / 256.0f) + EPS);
#pragma unroll
        for (int j = 0; j < 8; ++j) { u32x4 w; w.x = cvt_pk_bf16(v[8 * j] * rs, v[8 * j + 1] * rs); w.y = cvt_pk_bf16(v[8 * j + 2] * rs, v[8 * j + 3] * rs);
            w.z = cvt_pk_bf16(v[8 * j + 4] * rs, v[8 * j + 5] * rs); w.w = cvt_pk_bf16(v[8 * j + 6] * rs, v[8 * j + 7] * rs); st16_wt(ob + base + 8 * j, w); }
    }
}
__device__ __forceinline__ void final_phase(Frame& F, KArgsPtr a) {
    const int lane = F.lane, gw = F.vcu * NWAVES + F.wave, NGW = F.G * NWAVES;
    const float* H = (const float*)(F.ws + WS_H); const bf16_t* Y = (const bf16_t*)(F.ws + WS_YS); const float* g = a->in[31];
    for (int m = gw; m < T; m += NGW) {
        const size_t base = (size_t)m * DM + 4 * lane; f32x4 v[16]; float ss = 0.f;
#pragma unroll
        for (int j = 0; j < 16; ++j) { f32x4 x = *(const f32x4*)(H + base + 256 * j); const u32x2 ya = *(const u32x2*)(Y + base + 256 * j), yb2 = *(const u32x2*)(Y + (size_t)T * DM + base + 256 * j);
            x.x += bf2f(ya.x & 0xffffu) + bf2f(yb2.x & 0xffffu); x.y += bf2f(ya.x >> 16) + bf2f(yb2.x >> 16); x.z += bf2f(ya.y & 0xffffu) + bf2f(yb2.y & 0xffffu); x.w += bf2f(ya.y >> 16) + bf2f(yb2.y >> 16);
            v[j] = x; ss += (x.x * x.x + x.y * x.y) + (x.z * x.z + x.w * x.w); }
        const float rs = 1.0f / sqrtf(wave_sum(ss) * (1.0f / DM) + EPS);
#pragma unroll
        for (int j = 0; j < 16; ++j) { const f32x4 gg = *(const f32x4*)(g + 4 * lane + 256 * j); *(f32x4*)(a->out + base + 256 * j) = v[j] * rs * gg; }
    }
}

constexpr int NPHASE = 17;
#ifndef DBG_ROW_WORDS
#define DBG_ROW_WORDS 1024
#endif
#ifndef DBG_COL_LO
#define DBG_COL_LO 0
#define DBG_COL_HI 4096
#endif
#ifndef PHASE_MASK
#define PHASE_MASK 0x1FFFF
#endif
#define PH_BEGIN KArgsPtr a = launder_args(kp); Frame F = make_frame(a, lds); unsigned char* ws = F.ws; (void)ws; (void)F;
__device__ __forceinline__ void ph_u_gemm(KArgsPtr kp, LAS unsigned char* lds) { PH_BEGIN
    pg8::StaticOrder S; S.init(T, SW, F.G, F.bid);
    pg8::EpiRowScaleBf16 E{(bf16_t*)(ws + WS_UB), SW, (const float*)(ws + WS_RSTD), 0, 0};
    pg8::gemm_phase<pg8::EpiRowScaleBf16, pg8::StaticOrder, false>(lds, (const bf16_t*)(ws + WS_XB), (const bf16_t*)(ws + WS_WIN), DM, S, E, nullptr); }
__device__ __forceinline__ void ph_glu_gemm(KArgsPtr kp, LAS unsigned char* lds) { PH_BEGIN
    pg8::StaticOrder S; S.init(T, 2 * DM, F.G, F.bid);
    pg8::EpiGlu E{a->in[0], (float*)(ws + WS_H)};
    pg8::gemm_phase<pg8::EpiGlu, pg8::StaticOrder, false>(lds, (const bf16_t*)(ws + WS_YB), (const bf16_t*)(ws + WS_GLU), SW, S, E, nullptr); }
__device__ __forceinline__ void ph_qkv_gemm(KArgsPtr kp, LAS unsigned char* lds) { PH_BEGIN
    pg8::StaticOrder S; S.init(T, 3 * AW, F.G, F.bid);
    pg8::EpiRowScaleBf16 E{(bf16_t*)(ws + WS_Q), AW, (const float*)(ws + WS_RSTD), AW, (size_t)T * AW};
    pg8::gemm_phase<pg8::EpiRowScaleBf16, pg8::StaticOrder, false>(lds, (const bf16_t*)(ws + WS_XB), (const bf16_t*)(ws + WS_QKV), DM, S, E, nullptr); }
__device__ __forceinline__ void ph_wo_gemm(KArgsPtr kp, LAS unsigned char* lds) { PH_BEGIN
    pg8::StaticOrder S; S.init(T, DM, F.G, F.bid);
    pg8::EpiResAdd E{(float*)(ws + WS_H)};
    pg8::gemm_phase<pg8::EpiResAdd, pg8::StaticOrder, false>(lds, (const bf16_t*)(ws + WS_OB), (const bf16_t*)(ws + WS_WO), AW, S, E, nullptr); }
__device__ __forceinline__ void ph_router(KArgsPtr kp, LAS unsigned char* lds, int li) { PH_BEGIN
    rn_phase<false, true>(F, (float*)(ws + WS_H), nullptr, (bf16_t*)(ws + WS_XB), (float*)(ws + WS_RSTD), (const float*)(ws + WS_WRT) + (size_t)li * 32 * DM, a->in[23] + li * 4, a->in[25] + li * NE,
                          F.ctl + CW_CNT + li * NE * 64, (int*)(ws + WS_LIST), (float*)(ws + WS_LIST + 512 * 1024)); }
__device__ __forceinline__ void ph_combine(KArgsPtr kp, LAS unsigned char* lds) { PH_BEGIN
    rn_phase<true, false>(F, (float*)(ws + WS_H), (const bf16_t*)(ws + WS_YS), (bf16_t*)(ws + WS_XB), (float*)(ws + WS_RSTD), nullptr, nullptr, nullptr, nullptr, nullptr, nullptr); }
__device__ __forceinline__ void ph_gateup(KArgsPtr kp, LAS unsigned char* lds, int li) { PH_BEGIN
    const int n = build_group<false>(F, F.ctl + CW_CNT + li * NE * 64, (const int*)(ws + WS_LIST), (const float*)(ws + WS_LIST + 512 * 1024), (const float*)(ws + WS_RSTD), 8, DM * 2);
    pg8::ListOrder S{(const LAS int*)(lds + TAB_OFF + 128), n};
    pg8::EpiGateUp E{(bf16_t*)(ws + WS_HM), (const LAS float*)(lds + TAB_OFF + 256 + 8 * 1024), (const LAS float*)(lds + TAB_OFF + 256 + 16 * 1024)};
    pg8::gemm_phase<pg8::EpiGateUp, pg8::ListOrder, true>(lds, (const bf16_t*)(ws + WS_XB), (const bf16_t*)(ws + WS_GU) + (size_t)li * NE * 2048 * DM, DM, S, E, (const LAS unsigned*)(lds + TAB_OFF + 256)); }
__device__ __forceinline__ void ph_down(KArgsPtr kp, LAS unsigned char* lds, int li) { PH_BEGIN
    const int n = build_group<true>(F, F.ctl + CW_CNT + li * NE * 64, (const int*)(ws + WS_LIST), (const float*)(ws + WS_LIST + 512 * 1024), (const float*)(ws + WS_RSTD), 16, 0);
    pg8::ListOrder S{(const LAS int*)(lds + TAB_OFF + 128), n};
    pg8::EpiDown E{(bf16_t*)(ws + WS_YS), (const LAS unsigned*)(lds + TAB_OFF + 256)};
    pg8::gemm_phase<pg8::EpiDown, pg8::ListOrder, false>(lds, (const bf16_t*)(ws + WS_HM), (const bf16_t*)(ws + WS_DN) + (size_t)li * NE * DM * FF, FF, S, E, nullptr); }
__device__ __forceinline__ void ph_prologue(KArgsPtr kp, LAS unsigned char* lds) { PH_BEGIN p0_prologue(F, a); }
__device__ __forceinline__ void ph_scan1(KArgsPtr kp, LAS unsigned char* lds) { PH_BEGIN
    scan_phase<1>(F, a); }
__device__ __forceinline__ void ph_scan2(KArgsPtr kp, LAS unsigned char* lds) { PH_BEGIN scan_phase<2>(F, a); }
__device__ __forceinline__ void ph_attn(KArgsPtr kp, LAS unsigned char* lds) { PH_BEGIN att::attn_phase(ws, (char*)lds, F.G, F.bid); }
__device__ __forceinline__ void ph_diff(KArgsPtr kp, LAS unsigned char* lds) { PH_BEGIN diff_phase(F, a); }
__device__ __forceinline__ void ph_final(KArgsPtr kp, LAS unsigned char* lds) { PH_BEGIN final_phase(F, a); }

__device__ __forceinline__ void ph_debug(KArgsPtr kp0, LAS unsigned char* lds) {
    KArgsPtr kp = launder_args(kp0);

        XcdBarrier b; b.bar = (unsigned*)(kp->ws + WS_CTL) + CW_BAR; b.x = xb_xcc_id(); b.st = (volatile LAS unsigned*)(lds + MISC_OFF) + 8; xcd_barrier(b);
        const int dtid = tid_opaque(), dbid = bid_opaque(), dgrid = grid_opaque();
        if (kp->dbg_kind == 12) { const float* dbg = (const float*)(kp->ws + WS_OC); float* o12 = kp->out; _Pragma("nounroll") for (size_t i = (size_t)dbid * 512 + dtid; i < (size_t)T * DM; i += (size_t)dgrid * 512) o12[i] = dbg[i & 2047]; return; }
        if (kp->dbg_kind == 10) {
            const int lane = dtid & 63, gw = dbid * 8 + (dtid >> 6), ngw = dgrid * 8; float* o10 = kp->out;
            _Pragma("nounroll") for (int r = gw; r < T; r += ngw) { const unsigned* p = (const unsigned*)(kp->ws + kp->dbg_off) + (size_t)r * DBG_ROW_WORDS; unsigned c = 0;
                _Pragma("nounroll") for (int j = lane; j < DBG_ROW_WORDS; j += 64) { const unsigned w = p[j]; c += (w ^ (w >> 16)) * 2654435761u; c = (c << 5) | (c >> 27); }
                for (int off2 = 1; off2 < 64; off2 <<= 1) c += __shfl_xor(c, off2);
                const float v = (float)(c & 0xFFFFu);
                _Pragma("nounroll") for (int j = lane; j < DM; j += 64) o10[(size_t)r * DM + j] = v; }
            return; }
        const size_t n = (size_t)T * DM; float* o = kp->out;
        _Pragma("nounroll") for (size_t i = (size_t)dbid * 512 + dtid; i < n; i += (size_t)dgrid * 512) {
            if (kp->dbg_kind == 9) { o[i] = (float)(((const unsigned*)kp->in[0])[i] & 0xFFFFu); }
            else if (kp->dbg_kind == 7) { o[i] = (float)(((const unsigned*)(kp->ws + kp->dbg_off))[i] & 0xFFFFu); }
            else if (kp->dbg_kind == 6) { o[i] = ((const float*)(kp->ws + WS_H))[i] - kp->in[0][i]; }
            else if (kp->dbg_kind == 5) { const bf16_t* q = (const bf16_t*)(kp->ws + WS_Q); o[i] = bf2f(q[i]) + 2.f * bf2f(q[i + n]) + 4.f * bf2f(q[i + 2 * n]); }
            else if (kp->dbg_kind == 4) { const int col = (int)(i % DM); o[i] = (col >= DBG_COL_LO && col < DBG_COL_HI) ? bf2f(((const bf16_t*)(kp->ws + kp->dbg_off))[i]) : 0.f; }
            else if (kp->dbg_kind == 1) o[i] = bf2f(((const bf16_t*)(kp->ws + kp->dbg_off))[i]); else o[i] = ((const float*)(kp->ws + kp->dbg_off))[i]; }

}
__device__ __forceinline__ bool ph_in(KArgsPtr kp, int k) { asm volatile("" : "+s"(kp)); return kp->ph_lo <= k && k < kp->ph_hi; }
__device__ __forceinline__ void ph_seam(KArgsPtr kp, LAS unsigned char* lds, int k) {
    asm volatile("" : "+s"(kp));
    if (kp->ph_lo <= k && k + 1 < kp->ph_hi) { XcdBarrier b; b.bar = (unsigned*)(kp->ws + WS_CTL) + CW_BAR; b.x = xb_xcc_id(); b.st = (volatile LAS unsigned*)(lds + MISC_OFF) + 8; xcd_barrier(b);
#ifdef DOUBLE_BARRIER
        for (int extra = 1; extra < DOUBLE_BARRIER; ++extra) xcd_barrier(b);
#endif
    }
}
__global__ void __launch_bounds__(NWAVES * 64, 2) yoco_fwd(Args args) {
    extern __shared__ __attribute__((aligned(16))) unsigned char lds_raw[];
    LAS unsigned char* lds = (LAS unsigned char*)lds_raw;
    KArgsPtr kp = (KArgsPtr)__builtin_amdgcn_kernarg_segment_ptr();
#ifdef DBG_DELAY_TICKS
    { const unsigned long long t0 = __builtin_amdgcn_s_memrealtime(); while (__builtin_amdgcn_s_memrealtime() - t0 < (unsigned long long)DBG_DELAY_TICKS) __builtin_amdgcn_s_sleep(10); }
#endif
    { volatile LAS unsigned* MISC = (volatile LAS unsigned*)(lds + MISC_OFF);
      if (threadIdx.x < 64) MISC[threadIdx.x] = 0u;
      __syncthreads();
      (void)xcd_barrier_post((unsigned*)(args.ws + WS_CTL) + CW_BAR, MISC + 8); }
#define IN(k) (((PHASE_MASK >> ((k) & 31)) & 1) && ph_in(kp, (k)))
#define SEAM(k) ph_seam(kp, lds, (k))
    if (IN(0)) ph_prologue(kp, lds); SEAM(0);
    if (IN(1)) ph_u_gemm(kp, lds); SEAM(1);
    if (IN(2)) ph_scan1(kp, lds); SEAM(2);
    if (IN(3)) ph_scan2(kp, lds); SEAM(3);
    if (IN(4)) ph_glu_gemm(kp, lds); SEAM(4);
    if (IN(5)) ph_router(kp, lds, 0); SEAM(5);
    if (IN(6)) ph_gateup(kp, lds, 0); SEAM(6);
    if (IN(7)) ph_down(kp, lds, 0); SEAM(7);
    if (IN(8)) ph_combine(kp, lds); SEAM(8);
    if (IN(9)) ph_qkv_gemm(kp, lds); SEAM(9);
    if (IN(10)) ph_attn(kp, lds); SEAM(10);
    if (IN(11)) ph_diff(kp, lds); SEAM(11);
    if (IN(12)) ph_wo_gemm(kp, lds); SEAM(12);
    if (IN(13)) ph_router(kp, lds, 1); SEAM(13);
    if (IN(14)) ph_gateup(kp, lds, 1); SEAM(14);
    if (IN(15)) ph_down(kp, lds, 1); SEAM(15);
    if (IN(16)) ph_final(kp, lds);
    if (kp->dbg_kind) ph_debug(kp, lds);
#undef IN
#undef SEAM
}

#ifndef MK_N_LAUNCHES
#define MK_N_LAUNCHES 1
#endif
extern "C" void kernel_launch(void* const* d_in, const int* in_sizes, int n_in, void* d_out, int out_size, void* d_ws, size_t ws_size, hipStream_t stream) {
    static int grid = 0;
    if (grid == 0) {
        if (n_in != 32 || out_size != T * DM || ws_size < WS_END) { fprintf(stderr, "kernel_launch: unexpected shapes (n_in %d out %d ws %zu)\n", n_in, out_size, ws_size); grid = -1; return; }
        int dev = 0, cus = 0, per_cu = 0;
        if (hipGetDevice(&dev) != hipSuccess || hipDeviceGetAttribute(&cus, hipDeviceAttributeMultiprocessorCount, dev) != hipSuccess) { grid = -1; return; }
        if (hipFuncSetAttribute((const void*)yoco_fwd, hipFuncAttributeMaxDynamicSharedMemorySize, LDS_BYTES) != hipSuccess) { fprintf(stderr, "kernel_launch: hipFuncSetAttribute failed\n"); grid = -1; return; }
        if (hipOccupancyMaxActiveBlocksPerMultiprocessor(&per_cu, (const void*)yoco_fwd, NWAVES * 64, LDS_BYTES) != hipSuccess || per_cu < 1) fprintf(stderr, "kernel_launch: occupancy query says %d\n", per_cu);
        (void)hipGetLastError();
        grid = cus;
    }
    if (grid < 0) return;
    (void)hipMemsetAsync((char*)d_ws + WS_CTL, 0, CTL_ZERO_BYTES, stream);
#ifdef DBG_ZERO_YS
    (void)hipMemsetAsync((char*)d_ws + WS_YS, 0, (size_t)2 * T * DM * 2, stream);
#endif
    Args a{};
    for (int i = 0; i < 32; ++i) a.in[i] = (const float*)d_in[i];
    a.out = (float*)d_out; a.ws = (unsigned char*)d_ws;
#ifdef DBG_STOP
    a.ph_lo = 0; a.ph_hi = DBG_STOP + 1; a.dbg_kind = DBG_KIND; a.dbg_off = (size_t)DBG_OFF_MIB * MiB;
    hipLaunchKernelGGL(yoco_fwd, dim3(grid), dim3(NWAVES * 64), LDS_BYTES, stream, a);
#elif MK_N_LAUNCHES == 1
    a.ph_lo = 0; a.ph_hi = NPHASE;
    hipLaunchKernelGGL(yoco_fwd, dim3(grid), dim3(NWAVES * 64), LDS_BYTES, stream, a);
#else
    for (int p = 0; p < NPHASE; ++p) { a.ph_lo = p; a.ph_hi = p + 1; hipLaunchKernelGGL(yoco_fwd, dim3(grid), dim3(NWAVES * 64), LDS_BYTES, stream, a); }
#endif
}
```

```cpp
#include <hip/hip_runtime.h>
#include <cstdio>
#include <cstdint>

#define LAS __attribute__((address_space(3)))
#define GAS __attribute__((address_space(1)))
typedef unsigned short bf16_t;
typedef short bf16x8 __attribute__((ext_vector_type(8)));
typedef short s16x4 __attribute__((ext_vector_type(4)));
typedef float f32x4 __attribute__((ext_vector_type(4)));
typedef float f32x2 __attribute__((ext_vector_type(2)));
typedef float f32x16 __attribute__((ext_vector_type(16)));
typedef unsigned u32x4 __attribute__((ext_vector_type(4)));
typedef unsigned u32x2 __attribute__((ext_vector_type(2)));

constexpr int BATCH = 2, SEQ = 4096, T = BATCH * SEQ, DM = 4096;
constexpr int SW = 2048, NG = 128, SJ = 16, SP = 64;
constexpr int NH = 16, HD = 128, AW = 4096;
constexpr int NE = 16, FF = 1024;
constexpr float EPS = 1e-6f;
constexpr float LAMBDA_INIT1 = 0.35550906759f;
constexpr int NSEG = 8, LSEG = SEQ / NSEG;

constexpr size_t MiB = 1u << 20;
constexpr size_t WS_CTL = 0, CTL_ZERO_BYTES = 1 * MiB;
constexpr size_t WS_WIN = 16 * MiB;
constexpr size_t WS_GLU = 32 * MiB;
constexpr size_t WS_QKV = 64 * MiB;
constexpr size_t WS_WO = 160 * MiB;
constexpr size_t WS_GU = 192 * MiB;
constexpr size_t WS_DN = 704 * MiB;
constexpr size_t WS_WRT = 960 * MiB;
constexpr size_t WS_RSTD = 961 * MiB;
constexpr size_t WS_LIST = 962 * MiB;
constexpr size_t WS_ENDS = 963 * MiB;
constexpr size_t WS_XB = 964 * MiB;
constexpr size_t WS_UB = 1028 * MiB;
constexpr size_t WS_YB = 1060 * MiB;
constexpr size_t WS_H = 1092 * MiB;
constexpr size_t WS_Q = 1220 * MiB;
constexpr size_t WS_OC = 1412 * MiB;
constexpr size_t WS_OB = 1540 * MiB;
constexpr size_t WS_YS = 1604 * MiB;
constexpr size_t WS_HM = 1732 * MiB;
constexpr size_t WS_END = 1772 * MiB;
constexpr int CW_BAR = 4096;
constexpr int CW_CNT = 16384;
constexpr int LISTCAP = 8192;

constexpr int RING_BYTES = 131072;
constexpr int MISC_OFF = RING_BYTES;
constexpr int TAB_OFF = RING_BYTES + 256;
constexpr int LDS_BYTES = 163840;
constexpr int NWAVES = 8;

#define LDS_WAIT() asm volatile("s_waitcnt lgkmcnt(0)" ::: "memory")
#define VM_WAIT() asm volatile("s_waitcnt vmcnt(0)" ::: "memory")
__device__ __forceinline__ unsigned f2bf(float f) { unsigned u = __builtin_bit_cast(unsigned, f); return (u + 0x7fffu + ((u >> 16) & 1u)) >> 16; }
__device__ __forceinline__ float bf2f(unsigned b) { return __builtin_bit_cast(float, b << 16); }
__device__ __forceinline__ unsigned cvt_pk_bf16(float lo, float hi) { unsigned r; asm volatile("v_cvt_pk_bf16_f32 %0, %1, %2" : "=v"(r) : "v"(lo), "v"(hi)); return r; }
__device__ __forceinline__ float wave_sum(float v) {
#pragma unroll
    for (int o = 1; o < 64; o <<= 1) v += __shfl_xor(v, o);
    return v;
}
__device__ __forceinline__ int tid_opaque() { int t = threadIdx.x; asm volatile("" : "+v"(t)); return t; }
__device__ __forceinline__ int bid_opaque() { int b = blockIdx.x; asm volatile("" : "+s"(b)); return b; }
__device__ __forceinline__ int grid_opaque() { int g = gridDim.x; asm volatile("" : "+s"(g)); return g; }
__device__ __forceinline__ float ld_coh(const float* p) { return __builtin_bit_cast(float, __hip_atomic_load((const unsigned*)p, __ATOMIC_RELAXED, __HIP_MEMORY_SCOPE_AGENT)); }
__device__ __forceinline__ int ld_coh(const int* p) { return (int)__hip_atomic_load((const unsigned*)p, __ATOMIC_RELAXED, __HIP_MEMORY_SCOPE_AGENT); }
__device__ __forceinline__ void st_coh(float* p, float v) { __hip_atomic_store((unsigned*)p, __builtin_bit_cast(unsigned, v), __ATOMIC_RELAXED, __HIP_MEMORY_SCOPE_AGENT); }
__device__ __forceinline__ void st_coh(int* p, int v) { __hip_atomic_store((unsigned*)p, (unsigned)v, __ATOMIC_RELAXED, __HIP_MEMORY_SCOPE_AGENT); }
#ifndef WT_STORES
#define WT_STORES 1
#endif
#if WT_STORES
__device__ __forceinline__ void st16_wt(void* p, u32x4 v) { asm volatile("global_store_dwordx4 %0, %1, off sc1\n\ts_nop 1" :: "v"(p), "v"(v) : "memory"); }
__device__ __forceinline__ void st8_wt(void* p, u32x2 v) { asm volatile("global_store_dwordx2 %0, %1, off sc1\n\ts_nop 1" :: "v"(p), "v"(v) : "memory"); }
__device__ __forceinline__ void st4_wt(void* p, unsigned v) { asm volatile("global_store_dword %0, %1, off sc1\n\ts_nop 1" :: "v"(p), "v"(v) : "memory"); }
__device__ __forceinline__ void st2_wt(void* p, unsigned v) { asm volatile("global_store_short %0, %1, off sc1\n\ts_nop 1" :: "v"(p), "v"(v) : "memory"); }
#else
__device__ __forceinline__ void st16_wt(void* p, u32x4 v) { *(u32x4*)p = v; }
__device__ __forceinline__ void st8_wt(void* p, u32x2 v) { *(u32x2*)p = v; }
__device__ __forceinline__ void st4_wt(void* p, unsigned v) { *(unsigned*)p = v; }
__device__ __forceinline__ void st2_wt(void* p, unsigned v) { *(unsigned short*)p = (unsigned short)v; }
#endif
__device__ __forceinline__ void st16_wt(void* p, f32x4 v) { st16_wt(p, __builtin_bit_cast(u32x4, v)); }
__device__ __forceinline__ float fast_sigmoid(float x) { return __builtin_amdgcn_rcpf(1.0f + __expf(-x)); }

#define XB_TMO      128
#define XB_XCNT(j)  (256  + 64 * (j))
#define XB_XSUB(j)  (1280 + 64 * (j))
#define XB_XGEN(j)  (2304 + 64 * (j))
#define XB_TOP      3328
#define XB_TOPGEN   3392
#define XCD_BAR_WORDS 3456
#define XB_SPIN_CAP (1u << 18)
__device__ __forceinline__ unsigned xb_ld(unsigned* p)              { return __hip_atomic_load(p, __ATOMIC_RELAXED, __HIP_MEMORY_SCOPE_AGENT); }
__device__ __forceinline__ unsigned xb_add(unsigned* p, unsigned v) { return __hip_atomic_fetch_add(p, v, __ATOMIC_RELAXED, __HIP_MEMORY_SCOPE_AGENT); }
__device__ __forceinline__ unsigned xb_xcc_id() { return (unsigned)__builtin_amdgcn_s_getreg((3 << 11) | 20) & 0xFu; }
#define XB_SPIN(cond, bar) do { unsigned _sp = 0; while (cond) { __builtin_amdgcn_s_sleep(1); \
    if ((++_sp & 255u) == 0u) { if (xb_ld(&(bar)[XB_TMO])) break; if (_sp > XB_SPIN_CAP) { atomicAdd(&(bar)[XB_TMO], 1u); break; } } } } while (0)
struct XcdBarrier { unsigned* bar; unsigned x; volatile LAS unsigned* st; };
__device__ __forceinline__ XcdBarrier xcd_barrier_post(unsigned* bar, volatile LAS unsigned* st) {
    XcdBarrier b; b.bar = bar; b.x = xb_xcc_id(); b.st = st;
    if (threadIdx.x == 0) (void)xb_add(&bar[XB_XCNT(b.x)], 1u);
    return b;
}
__device__ __forceinline__ void xcd_barrier_complete(unsigned* bar, unsigned x, unsigned& nloc, unsigned& nx) {
    const unsigned G = gridDim.x * gridDim.y * gridDim.z;
    unsigned sum, cnt, mine, sp = 0u;
    for (;;) {
        sum = 0u; cnt = 0u; mine = 0u;
#pragma unroll
        for (unsigned j = 0; j < 16; ++j) { const unsigned c = xb_ld(&bar[XB_XCNT(j)]); sum += c; cnt += (c > 0u) ? 1u : 0u; mine = (j == x) ? c : mine; }
        if (sum == G) break;
        __builtin_amdgcn_s_sleep(1);
        if ((++sp & 255u) == 0u) { if (xb_ld(&bar[XB_TMO])) break; if (sp > XB_SPIN_CAP) { atomicAdd(&bar[XB_TMO], 1u); break; } }
    }
    nloc = mine > 0u ? mine : 1u; nx = cnt > 0u ? cnt : 1u;
}
__device__ __forceinline__ void xcd_barrier(const XcdBarrier& b) {
    asm volatile("s_waitcnt vmcnt(0)" ::: "memory");
    __syncthreads();
    if (threadIdx.x == 0) {
        unsigned* bar = b.bar;
        __builtin_amdgcn_s_waitcnt(0);
        unsigned nloc = b.st[0], nx = b.st[1];
        if (nloc == 0u) { xcd_barrier_complete(bar, b.x, nloc, nx); b.st[0] = nloc; b.st[1] = nx; }
        const unsigned old = xb_add(&bar[XB_XSUB(b.x)], 1u);
        const unsigned gen = old / nloc;
        if (old + 1u == (gen + 1u) * nloc) {
            __builtin_amdgcn_fence(__ATOMIC_RELEASE, "");
            asm volatile("s_waitcnt vmcnt(0)" ::: "memory");
            const unsigned og = xb_add(&bar[XB_TOP], 1u);
            const unsigned tg = og / nx;
            if (og + 1u == (tg + 1u) * nx) xb_add(&bar[XB_TOPGEN], 1u);
            else XB_SPIN(xb_ld(&bar[XB_TOPGEN]) == tg, bar);
            __builtin_amdgcn_fence(__ATOMIC_ACQUIRE, "");
            xb_add(&bar[XB_XGEN(b.x)], 1u);
            asm volatile("s_waitcnt vmcnt(0)" ::: "memory");
        } else {
            XB_SPIN(xb_ld(&bar[XB_XGEN(b.x)]) == gen, bar);
            __builtin_amdgcn_fence(__ATOMIC_ACQUIRE, "");
            asm volatile("s_waitcnt vmcnt(0)" ::: "memory");
        }
    }
    __syncthreads();
}

#ifndef GEMM_DRAIN0
#define GEMM_DRAIN0 0
#endif
namespace pg8 {
constexpr int BM = 256, BK = 64, HALF = 128, HTB = HALF * BK * 2, NXCD = 8, WGM = 8;
__device__ __forceinline__ int lds_byte(int r, int c) { const int st = (r >> 4) * 2 + (c >> 5), rr = r & 15, cc = c & 31, ob = rr * 64 + cc * 2; return st * 1024 + (ob ^ (((ob >> 9) & 1) << 5)); }
__device__ __forceinline__ void stage_rc(int b, int& R, int& C) { const int st = b / 1024, sb = b % 1024, swz = sb ^ (((sb >> 9) & 1) << 5); R = (st >> 1) * 16 + swz / 64; C = (st & 1) * 32 + (swz % 64) / 2; }
__device__ __forceinline__ int perm32(int rho) { const int n = rho >> 4, i = rho & 15; return 8 * (i >> 2) + 4 * n + (i & 3); }
struct Unit { int pm, pn, bt; };
__device__ __forceinline__ void tile_of(int L, int nM, int nN, int& pm, int& pn) {
    const int nwg = nM * nN; int wgid = L;
    { const int q = nwg / NXCD, r = nwg % NXCD, xcd = wgid % NXCD, off = wgid / NXCD; wgid = (xcd < r ? xcd * (q + 1) : r * (q + 1) + (xcd - r) * q) + off; }
    const int nig = WGM * nN, gid = wgid / nig, fm = gid * WGM, gsz = (nM - fm) < WGM ? (nM - fm) : WGM;
    pm = fm + ((wgid % nig) % gsz); pn = (wgid % nig) / gsz;
}
struct StaticOrder {
    int nM, nN, nwg, G, c;
    __device__ void init(int M, int N, int G_, int c_) { nM = M / BM; nN = N / BM; nwg = nM * nN; G = G_; c = c_; }
    __device__ __forceinline__ bool next(int i, Unit& u) const {
        const long L = (long)i * G + c; if (L >= nwg) return false;
        tile_of((int)L, nM, nN, u.pm, u.pn); u.bt = u.pn; return true;
    }
};
struct ListOrder {
    const LAS int* ul; int n;
    __device__ __forceinline__ bool next(int i, Unit& u) const {
        if (i >= n) return false;
        u.pm = __builtin_amdgcn_readfirstlane(ul[3 * i]); u.pn = __builtin_amdgcn_readfirstlane(ul[3 * i + 1]); u.bt = __builtin_amdgcn_readfirstlane(ul[3 * i + 2]); return true;
    }
};

template <class Epi, class Sched, bool GATHER>
__device__ __forceinline__ void gemm_phase(LAS unsigned char* lds, const bf16_t* Abase, const bf16_t* Btbase, const int K, const Sched& S, const Epi& E, const LAS unsigned* gtab) {
    const int tid = tid_opaque(), wid = __builtin_amdgcn_readfirstlane(tid >> 6), lane = tid & 63, wr = wid >> 2, wc = wid & 3, fr = lane & 15, fq = lane >> 4;
    const int nt = K / BK;
    unsigned voffA[2], voffB[2]; int RA[2], CA2[2];
#pragma unroll
    for (int i = 0; i < 2; ++i) { int R, C; stage_rc(tid * 16 + i * 8192, R, C); const int Rb = Epi::PERM ? ((R & ~31) + perm32(R & 31)) : R;
        voffA[i] = (unsigned)(R * K + C) * 2u; voffB[i] = (unsigned)(Rb * K + C) * 2u; RA[i] = R; CA2[i] = C * 2; }
    const size_t kstep = (size_t)(BK * 2);
    const size_t hstep = (size_t)HALF * K * 2;
    const size_t tstep = 2 * hstep;
    const unsigned ldsw = (unsigned)wid * 1024u;
    const int aoff = lds_byte(wr * 64 + fr, fq * 8), boff = lds_byte(wc * 32 + fr, fq * 8);
#define PG8_SA(b, h) (((b) * 2 + (h)) * HTB)
#define PG8_SB(b, h) ((4 + (b) * 2 + (h)) * HTB)
#define PG8_STAGE(bufoff, gbase, voff) do { _Pragma("unroll") for (int _i = 0; _i < 2; ++_i) \
        __builtin_amdgcn_global_load_lds((const unsigned*)((const char*)(gbase) + (voff)[_i]), (LAS unsigned*)(lds + (bufoff) + ldsw + _i * 8192), 16, 0, 0); } while (0)
#define PG8_STGA(bufoff, ptr, h, goff) do { if constexpr (GATHER) { PG8_STAGE(bufoff, ptr, goff[h]); } else { PG8_STAGE(bufoff, (ptr) + (h) * hstep, voffA); } } while (0)
#define PG8_LDA(dst, b, h) do { _Pragma("unroll") for (int m = 0; m < 4; ++m) _Pragma("unroll") for (int k = 0; k < 2; ++k) dst[m][k] = *(const LAS bf16x8*)(lds + PG8_SA(b, h) + aoff + m * 2048 + k * 1024); } while (0)
#define PG8_LDB(dst, b, h) do { _Pragma("unroll") for (int n = 0; n < 2; ++n) _Pragma("unroll") for (int k = 0; k < 2; ++k) dst[n][k] = *(const LAS bf16x8*)(lds + PG8_SB(b, h) + boff + n * 2048 + k * 1024); } while (0)
#define PG8_MMA(ai, bj, At, Bt) do { __builtin_amdgcn_s_setprio(1); _Pragma("unroll") for (int m = 0; m < 4; ++m) _Pragma("unroll") for (int n = 0; n < 2; ++n) _Pragma("unroll") for (int k = 0; k < 2; ++k) \
        acc[ai][bj][m][n] = __builtin_amdgcn_mfma_f32_16x16x32_bf16(Bt[n][k], At[m][k], acc[ai][bj][m][n], 0, 0, 0); __builtin_amdgcn_s_setprio(0); } while (0)
#define PG8_WAIT_V(n) asm volatile("s_waitcnt vmcnt(" #n ")" ::: "memory")
#define PG8_WAIT_L(n) asm volatile("s_waitcnt lgkmcnt(" #n ")" ::: "memory")
#define PG8_BAR __builtin_amdgcn_s_barrier()
#define PG8_SCHED __builtin_amdgcn_sched_barrier(0)
    Unit cur, nxt; int ui = 0;
    if (!S.next(0, cur)) return;
    f32x4 acc[2][2][4][2];
#pragma unroll
    for (int a = 0; a < 2; ++a)
#pragma unroll
        for (int b = 0; b < 2; ++b)
#pragma unroll
            for (int m = 0; m < 4; ++m)
#pragma unroll
                for (int n = 0; n < 2; ++n) acc[a][b][m][n] = (f32x4){0.f, 0.f, 0.f, 0.f};
    bf16x8 At[4][2], B0[2][2], B1[2][2];
    unsigned gC[2][2], gN[2][2];
    if constexpr (GATHER) {
#pragma unroll
        for (int h = 0; h < 2; ++h)
#pragma unroll
            for (int i = 0; i < 2; ++i) { gC[h][i] = gtab[0 * 256 + h * HALF + RA[i]] + (unsigned)CA2[i]; gN[h][i] = gC[h][i]; }
    }
    const char* cA = GATHER ? (const char*)Abase : (const char*)Abase + (size_t)cur.pm * tstep; const char* cB = (const char*)Btbase + (size_t)cur.bt * tstep;
    PG8_STAGE(PG8_SB(0, 0), cB, voffB); PG8_STAGE(PG8_SB(0, 1), cB + hstep, voffB); PG8_STGA(PG8_SA(0, 0), cA, 0, gC); PG8_STGA(PG8_SA(0, 1), cA, 1, gC);
    if (wr == 1) PG8_BAR;
#if GEMM_DRAIN0
    PG8_WAIT_V(0); PG8_BAR;
#else
    PG8_WAIT_V(2); PG8_BAR;
#endif
    PG8_STAGE(PG8_SB(1, 0), cB + kstep, voffB); PG8_STGA(PG8_SA(1, 0), cA + kstep, 0, gC); PG8_STAGE(PG8_SB(1, 1), cB + hstep + kstep, voffB);
#if GEMM_DRAIN0
    PG8_WAIT_V(0); PG8_BAR;
#else
    PG8_WAIT_V(6); PG8_BAR;
#endif
    for (;;) {
        const bool has_next = S.next(ui + 1, nxt);
        const char* nA = GATHER ? (const char*)Abase : (has_next ? (const char*)Abase + (size_t)nxt.pm * tstep : cA); const char* nB = has_next ? (const char*)Btbase + (size_t)nxt.bt * tstep : cB;
        if constexpr (GATHER) {
            if (has_next) {
#pragma unroll
                for (int h = 0; h < 2; ++h)
#pragma unroll
                    for (int i = 0; i < 2; ++i) gN[h][i] = gtab[(ui + 1) * 256 + h * HALF + RA[i]] + (unsigned)CA2[i];
            } else {
#pragma unroll
                for (int h = 0; h < 2; ++h)
#pragma unroll
                    for (int i = 0; i < 2; ++i) gN[h][i] = gC[h][i];
            }
        }
        for (int t = 0; t < nt; t += 2) {
            const bool last = (t == nt - 2);
            const char* a1 = cA + (size_t)(t + 1) * kstep;
            const char* a2 = last ? nA : cA + (size_t)(t + 2) * kstep; const char* b2 = last ? nB : cB + (size_t)(t + 2) * kstep;
            const char* a3 = a2 + kstep; const char* b3 = b2 + kstep;
            unsigned g2[2][2];
            if constexpr (GATHER) {
#pragma unroll
                for (int h = 0; h < 2; ++h)
#pragma unroll
                    for (int i = 0; i < 2; ++i) g2[h][i] = last ? gN[h][i] : gC[h][i];
            }
#if GEMM_DRAIN0
            PG8_LDB(B0, 0, 0); PG8_LDB(B1, 0, 1); PG8_SCHED; PG8_LDA(At, 0, 0); PG8_WAIT_V(0); PG8_STGA(PG8_SA(1, 1), a1, 1, gC);
            PG8_WAIT_L(0); PG8_BAR; PG8_MMA(0, 0, At, B0); PG8_MMA(0, 1, At, B1); PG8_BAR; PG8_SCHED;
            PG8_LDA(At, 0, 1); PG8_WAIT_V(0); PG8_STAGE(PG8_SB(0, 0), b2, voffB); PG8_STAGE(PG8_SB(0, 1), b2 + hstep, voffB); PG8_STGA(PG8_SA(0, 0), a2, 0, g2);
            PG8_WAIT_L(0); PG8_BAR; PG8_MMA(1, 0, At, B0); PG8_MMA(1, 1, At, B1); PG8_BAR; PG8_SCHED;
            PG8_LDB(B0, 1, 0); PG8_LDB(B1, 1, 1); PG8_SCHED; PG8_LDA(At, 1, 0); PG8_WAIT_V(0); PG8_STGA(PG8_SA(0, 1), a2, 1, g2);
            PG8_WAIT_L(0); PG8_BAR; PG8_MMA(0, 0, At, B0); PG8_MMA(0, 1, At, B1); PG8_BAR; PG8_SCHED;
            PG8_LDA(At, 1, 1); PG8_WAIT_V(0); PG8_STAGE(PG8_SB(1, 0), b3, voffB); PG8_STAGE(PG8_SB(1, 1), b3 + hstep, voffB); PG8_STGA(PG8_SA(1, 0), a3, 0, g2);
            PG8_WAIT_L(0); PG8_BAR; PG8_MMA(1, 0, At, B0); PG8_MMA(1, 1, At, B1); PG8_BAR; PG8_SCHED;
#else
            PG8_LDB(B0, 0, 0); PG8_LDB(B1, 0, 1); PG8_SCHED; PG8_LDA(At, 0, 0); PG8_STGA(PG8_SA(1, 1), a1, 1, gC);
            PG8_WAIT_V(8); PG8_WAIT_L(0); PG8_BAR; PG8_MMA(0, 0, At, B0); PG8_MMA(0, 1, At, B1); PG8_BAR; PG8_SCHED;
            PG8_LDA(At, 0, 1); PG8_STAGE(PG8_SB(0, 0), b2, voffB); PG8_STAGE(PG8_SB(0, 1), b2 + hstep, voffB); PG8_STGA(PG8_SA(0, 0), a2, 0, g2);
            PG8_WAIT_V(8); PG8_WAIT_L(0); PG8_BAR; PG8_MMA(1, 0, At, B0); PG8_MMA(1, 1, At, B1); PG8_BAR; PG8_SCHED;
            PG8_LDB(B0, 1, 0); PG8_LDB(B1, 1, 1); PG8_SCHED; PG8_LDA(At, 1, 0); PG8_STGA(PG8_SA(0, 1), a2, 1, g2);
            PG8_WAIT_V(8); PG8_WAIT_L(0); PG8_BAR; PG8_MMA(0, 0, At, B0); PG8_MMA(0, 1, At, B1); PG8_BAR; PG8_SCHED;
            PG8_LDA(At, 1, 1); PG8_STAGE(PG8_SB(1, 0), b3, voffB); PG8_STAGE(PG8_SB(1, 1), b3 + hstep, voffB); PG8_STGA(PG8_SA(1, 0), a3, 0, g2);
            PG8_WAIT_V(8); PG8_WAIT_L(0); PG8_BAR; PG8_MMA(1, 0, At, B0); PG8_MMA(1, 1, At, B1); PG8_BAR; PG8_SCHED;
#endif
        }
        if (wr == 0) PG8_BAR;
        E(acc, cur, ui, wr, wc, fr, fq);
        if (!has_next) break;
#pragma unroll
        for (int a = 0; a < 2; ++a)
#pragma unroll
            for (int b = 0; b < 2; ++b)
#pragma unroll
                for (int m = 0; m < 4; ++m)
#pragma unroll
                    for (int n = 0; n < 2; ++n) acc[a][b][m][n] = (f32x4){0.f, 0.f, 0.f, 0.f};
        cur = nxt; cA = nA; cB = nB; ++ui;
        if constexpr (GATHER) {
#pragma unroll
            for (int h = 0; h < 2; ++h)
#pragma unroll
                for (int i = 0; i < 2; ++i) gC[h][i] = gN[h][i];
        }
        if (wr == 1) PG8_BAR;
    }
    PG8_WAIT_V(0);
    PG8_BAR;
#undef PG8_SA
#undef PG8_SB
#undef PG8_STAGE
#undef PG8_STGA
#undef PG8_LDA
#undef PG8_LDB
#undef PG8_MMA
#undef PG8_WAIT_V
#undef PG8_WAIT_L
#undef PG8_BAR
#undef PG8_SCHED
}

typedef f32x4 Acc[2][2][4][2];
struct EpiRowScaleBf16 {
    static constexpr bool PERM = true;
    bf16_t* O; int ldc; const float* rs; int split_cols; size_t split_stride;
    __device__ __forceinline__ void operator()(const Acc& acc, const Unit& u, int, int wr, int wc, int fr, int fq) const {
        const int row0 = u.pm * BM + wr * 64 + fr; int colt = u.pn * BM; bf16_t* base = O;
        if (split_cols) { const int t = colt / split_cols; base += (size_t)t * split_stride; colt -= t * split_cols; }
        const int col0 = colt + wc * 32 + 8 * fq;
#pragma unroll
        for (int ai = 0; ai < 2; ++ai)
#pragma unroll
            for (int m = 0; m < 4; ++m) { const int row = row0 + ai * HALF + m * 16; const float s = ld_coh(rs + row); bf16_t* rowp = base + (size_t)row * ldc + col0;
#pragma unroll
                for (int bj = 0; bj < 2; ++bj) { const f32x4 v0 = acc[ai][bj][m][0] * s, v1 = acc[ai][bj][m][1] * s;
                    u32x4 w; w.x = cvt_pk_bf16(v0[0], v0[1]); w.y = cvt_pk_bf16(v0[2], v0[3]); w.z = cvt_pk_bf16(v1[0], v1[1]); w.w = cvt_pk_bf16(v1[2], v1[3]);
                    st16_wt(rowp + bj * HALF, w); } }
    }
};
struct EpiGlu {
    static constexpr bool PERM = false;
    const float* X; float* H;
    __device__ __forceinline__ void operator()(const Acc& acc, const Unit& u, int, int wr, int wc, int fr, int fq) const {
        const int row0 = u.pm * BM + wr * 64 + fr, col0 = u.pn * HALF + wc * 32 + 4 * fq;
#pragma unroll
        for (int ai = 0; ai < 2; ++ai)
#pragma unroll
            for (int m = 0; m < 4; ++m) { const size_t off = (size_t)(row0 + ai * HALF + m * 16) * DM + col0;
#pragma unroll
                for (int n = 0; n < 2; ++n) { const f32x4 a = acc[ai][0][m][n], b = acc[ai][1][m][n]; const f32x4 xv = *(const f32x4*)(X + off + n * 16);
                    f32x4 o; o[0] = xv[0] + a[0] * fast_sigmoid(b[0]); o[1] = xv[1] + a[1] * fast_sigmoid(b[1]); o[2] = xv[2] + a[2] * fast_sigmoid(b[2]); o[3] = xv[3] + a[3] * fast_sigmoid(b[3]);
                    st16_wt(H + off + n * 16, o); } }
    }
};
struct EpiGateUp {
    static constexpr bool PERM = true;
    bf16_t* Hm; const LAS float* tabR; const LAS float* tabW;
    __device__ __forceinline__ void operator()(const Acc& acc, const Unit& u, int ui, int wr, int wc, int fr, int fq) const {
        const int col0 = u.pn * HALF + wc * 32 + 8 * fq;
#pragma unroll
        for (int ai = 0; ai < 2; ++ai)
#pragma unroll
            for (int m = 0; m < 4; ++m) { const int rl = ai * HALF + wr * 64 + m * 16 + fr; const float r = tabR[ui * 256 + rl], w = tabW[ui * 256 + rl];
                float hv[8];
#pragma unroll
                for (int n = 0; n < 2; ++n)
#pragma unroll
                    for (int j = 0; j < 4; ++j) { const float g = acc[ai][0][m][n][j] * r, up = acc[ai][1][m][n][j] * r; hv[n * 4 + j] = g * fast_sigmoid(g) * up * w; }
                u32x4 o; o.x = cvt_pk_bf16(hv[0], hv[1]); o.y = cvt_pk_bf16(hv[2], hv[3]); o.z = cvt_pk_bf16(hv[4], hv[5]); o.w = cvt_pk_bf16(hv[6], hv[7]);
                st16_wt(Hm + (size_t)(u.pm * BM + rl) * FF + col0, o); }
    }
};
struct EpiDown {
    static constexpr bool PERM = true;
    bf16_t* Y; const LAS unsigned* tabD;
    __device__ __forceinline__ void operator()(const Acc& acc, const Unit& u, int ui, int wr, int wc, int fr, int fq) const {
        const int col0 = u.pn * BM + wc * 32 + 8 * fq;
#pragma unroll
        for (int ai = 0; ai < 2; ++ai)
#pragma unroll
            for (int m = 0; m < 4; ++m) { const int rl = ai * HALF + wr * 64 + m * 16 + fr; const unsigned d = tabD[ui * 256 + rl];
                if (d != 0xFFFFFFFFu) { bf16_t* rowp = Y + (size_t)d * DM + col0;
#pragma unroll
                    for (int bj = 0; bj < 2; ++bj) { const f32x4 v0 = acc[ai][bj][m][0], v1 = acc[ai][bj][m][1];
                        u32x4 w; w.x = cvt_pk_bf16(v0[0], v0[1]); w.y = cvt_pk_bf16(v0[2], v0[3]); w.z = cvt_pk_bf16(v1[0], v1[1]); w.w = cvt_pk_bf16(v1[2], v1[3]);
                        st16_wt(rowp + bj * HALF, w); } } }
    }
};
struct EpiResAdd {
    static constexpr bool PERM = false;
    float* H;
    __device__ __forceinline__ void operator()(const Acc& acc, const Unit& u, int, int wr, int wc, int fr, int fq) const {
        const int row0 = u.pm * BM + wr * 64 + fr, col0 = u.pn * BM + wc * 32 + 4 * fq;
#pragma unroll
        for (int ai = 0; ai < 2; ++ai)
#pragma unroll
            for (int m = 0; m < 4; ++m) { float* rowp = H + (size_t)(row0 + ai * HALF + m * 16) * DM + col0;
#pragma unroll
                for (int bj = 0; bj < 2; ++bj)
#pragma unroll
                    for (int n = 0; n < 2; ++n) { f32x4* p = (f32x4*)(rowp + bj * HALF + n * 16); const f32x4 t = *p + acc[ai][bj][m][n]; st16_wt(p, t); } }
    }
};
}

struct Args { const float* in[32]; float* out; unsigned char* ws; int ph_lo, ph_hi; int dbg_kind, dbg_pad; size_t dbg_off; };
typedef const __attribute__((address_space(4))) Args* KArgsPtr;
struct Frame {
    LAS unsigned char* lds; unsigned* ctl;
    int tid, lane, wave, vcu, G, bid;
    unsigned char* ws;
};
__device__ __forceinline__ KArgsPtr launder_args(KArgsPtr kp) { asm volatile("" : "+s"(kp)); return kp; }
__device__ __forceinline__ Frame make_frame(KArgsPtr a, LAS unsigned char* lds) {
    Frame F; { unsigned lb = (unsigned)(uintptr_t)lds; asm volatile("" : "+s"(lb)); F.lds = (LAS unsigned char*)(uintptr_t)lb; } F.tid = tid_opaque(); F.lane = F.tid & 63; F.wave = __builtin_amdgcn_readfirstlane(F.tid >> 6);
    F.G = grid_opaque(); F.bid = bid_opaque(); { const int bx = F.bid; F.vcu = (F.G % 8 == 0) ? (bx % 8) * (F.G / 8) + bx / 8 : bx; }
    F.ws = a->ws; F.ctl = (unsigned*)(F.ws + WS_CTL);
    return F;
}

__device__ __forceinline__ void conv_tile(const float* __restrict__ W, int N, int k0, int n0, const float* __restrict__ gain, int gmask, float gscale,
                                          bf16_t* __restrict__ dst, int ldk, int drow0, LAS unsigned* scr, int lane) {
    const int kk = lane >> 4, nq = lane & 15;
    f32x4 v[16];
#pragma unroll
    for (int i = 0; i < 16; ++i) v[i] = *(const f32x4*)(W + (size_t)(k0 + 2 * kk + (i & 1) + 8 * (i >> 1)) * N + n0 + 4 * nq);
#pragma unroll
    for (int ip = 0; ip < 8; ++ip) {
        const int k = k0 + 2 * kk + 8 * ip;
        const float g0 = gain ? gain[k & gmask] * gscale : 1.0f, g1 = gain ? gain[(k + 1) & gmask] * gscale : 1.0f;
#pragma unroll
        for (int j = 0; j < 4; ++j) { const int n = 4 * nq + j; scr[n * 32 + ((kk + 4 * ip) ^ (nq << 1))] = cvt_pk_bf16(v[2 * ip][j] * g0, v[2 * ip + 1][j] * g1); }
    }
    LDS_WAIT();
#pragma unroll
    for (int jj = 0; jj < 8; ++jj) {
        const int n = (lane >> 3) + 8 * jj, c = lane & 7;
        u32x4 w = *(const LAS u32x4*)(scr + n * 32 + 4 * (c ^ jj));
        if ((n >> 2) & 1) w = (u32x4){w.z, w.w, w.x, w.y};
        st16_wt(dst + (size_t)(drow0 + n) * ldk + k0 + 8 * c, w);
    }
    LDS_WAIT();
}
__device__ __forceinline__ int ileave(int n0) { return (n0 >> 7) * 256 + (n0 & 127); }

__device__ __forceinline__ void p0_prologue(Frame& F, KArgsPtr a) {
    LAS unsigned* scr = (LAS unsigned*)(F.lds + F.wave * 8192);
    const int gw = F.vcu * NWAVES + F.wave, NGW = F.G * NWAVES, lane = F.lane;
    unsigned char* ws = F.ws;
    constexpr int T_WIN = 64 * 32, T_GL = 32 * 64, T_SQ = 64 * 64, T_EXP = 3 * 1024;
    constexpr int O_GLA = T_WIN, O_GLB = O_GLA + T_GL, O_Q = O_GLB + T_GL, O_K = O_Q + T_SQ, O_V = O_K + T_SQ, O_O = O_V + T_SQ, O_MOE = O_O + T_SQ, NT_ALL = O_MOE + 32 * T_EXP;
    for (int it = gw; it < NT_ALL; it += NGW) {
        if (it < O_GLA) { const int r = it, kb = r / 32, nb = r % 32;
            conv_tile(a->in[1], SW, kb * 64, nb * 64, a->in[29], -1, 1.f, (bf16_t*)(ws + WS_WIN), DM, nb * 64, scr, lane); }
        else if (it < O_Q) { const int half = it >= O_GLB; const int r = it - (half ? O_GLB : O_GLA), kb = r / 64, nb = r % 64;
            conv_tile(half ? a->in[11] : a->in[10], DM, kb * 64, nb * 64, nullptr, -1, 1.f, (bf16_t*)(ws + WS_GLU), SW, ileave(nb * 64) + half * 128, scr, lane); }
        else if (it < O_O) { const int which = (it - O_Q) / T_SQ; const int r = (it - O_Q) % T_SQ, kb = r / 64, nb = r % 64;
            const float* W = which == 0 ? a->in[15] : (which == 1 ? a->in[13] : a->in[14]); const float* g = which == 0 ? a->in[29] + DM : a->in[12];
            conv_tile(W, AW, kb * 64, nb * 64, g, -1, 1.f, (bf16_t*)(ws + WS_QKV), DM, which * AW + nb * 64, scr, lane); }
        else if (it < O_MOE) { const int r = it - O_O, kb = r / 64, nb = r % 64;
            conv_tile(a->in[21], DM, kb * 64, nb * 64, a->in[20], 255, 1.0f - LAMBDA_INIT1, (bf16_t*)(ws + WS_WO), AW, nb * 64, scr, lane); }
        else { const int r0 = it - O_MOE, le = r0 / T_EXP, r1 = r0 % T_EXP, which = r1 / 1024, r = r1 % 1024, li = le / NE;
            if (which < 2) { const int kb = r / 16, nb = r % 16;
                conv_tile((which ? a->in[27] : a->in[26]) + (size_t)le * DM * FF, FF, kb * 64, nb * 64, a->in[30] + li * DM, -1, 1.f,
                          (bf16_t*)(ws + WS_GU) + (size_t)le * 2048 * DM, DM, ileave(nb * 64) + which * 128, scr, lane); }
            else { const int kb = r / 64, nb = r % 64;
                conv_tile(a->in[28] + (size_t)le * FF * DM, DM, kb * 64, nb * 64, nullptr, -1, 1.f, (bf16_t*)(ws + WS_DN) + (size_t)le * DM * FF, FF, nb * 64, scr, lane); } }
    }
    { float* WrT = (float*)(ws + WS_WRT);
      for (int i = (F.vcu * NWAVES + F.wave) * 64 + lane; i < 2 * 32 * DM; i += NGW * 64) { const int li = i / (32 * DM), c = (i / DM) % 32, k = i % DM; const float g = a->in[30][li * DM + k];
          float v = 0.f; if (c < 4) v = a->in[22][((size_t)li * DM + k) * 4 + c] * g; else if (c < 20) v = a->in[24][((size_t)li * DM + k) * 16 + (c - 4)] * g;
          st4_wt(WrT + i, __builtin_bit_cast(unsigned, v)); } }
    { const float* x = a->in[0]; bf16_t* xb = (bf16_t*)(ws + WS_XB); float* rstd = (float*)(ws + WS_RSTD);
      for (int m = gw; m < T; m += NGW) { const f32x4* xr = (const f32x4*)(x + (size_t)m * DM) + lane; u32x2* o8 = (u32x2*)(xb + (size_t)m * DM) + lane; float s = 0.f;
#pragma unroll
          for (int j = 0; j < 16; ++j) { const f32x4 v = xr[64 * j]; s += (v.x * v.x + v.y * v.y) + (v.z * v.z + v.w * v.w); st8_wt(o8 + 64 * j, (u32x2){cvt_pk_bf16(v.x, v.y), cvt_pk_bf16(v.z, v.w)}); }
          s = wave_sum(s); if (lane == 0) st_coh(rstd + m, 1.0f / sqrtf(s * (1.0f / DM) + EPS)); } }
}

template <bool COMBINE, bool ROUTER>
__device__ __forceinline__ void rn_phase(Frame& F, float* H, const bf16_t* Y, bf16_t* hb, float* rstd, const float* WrT, const float* bgroup, const float* brouter,
                                         unsigned* cnt, int* list_tok, float* list_w) {
    LAS float* pss = (LAS float*)(F.lds);
    LAS float* plg = (LAS float*)(F.lds + 1024);
    const int lane = F.lane, r = lane & 15, kq = lane >> 4, wave = F.wave;
    for (int task = F.vcu; task < T / 16; task += F.G) {
        const int row = task * 16 + r; const size_t rb = (size_t)row * DM + wave * 512 + 4 * kq;
        f32x4 acc0 = {0.f, 0.f, 0.f, 0.f}, acc1 = {0.f, 0.f, 0.f, 0.f}; float ss = 0.f;
        const float* w0p = WrT + (size_t)r * DM + wave * 512 + 4 * kq; const float* w1p = w0p + (size_t)16 * DM;
#pragma unroll 8
        for (int s = 0; s < 32; ++s) {
            f32x4 v = *(const f32x4*)(H + rb + 16 * s);
            if constexpr (COMBINE) { const u32x2 ya = *(const u32x2*)(Y + rb + 16 * s), yb2 = *(const u32x2*)(Y + (size_t)T * DM + rb + 16 * s);
                v.x += bf2f(ya.x & 0xffffu) + bf2f(yb2.x & 0xffffu); v.y += bf2f(ya.x >> 16) + bf2f(yb2.x >> 16); v.z += bf2f(ya.y & 0xffffu) + bf2f(yb2.y & 0xffffu); v.w += bf2f(ya.y >> 16) + bf2f(yb2.y >> 16);
                st16_wt(H + rb + 16 * s, v); }
            ss += (v.x * v.x + v.y * v.y) + (v.z * v.z + v.w * v.w);
            st8_wt(hb + rb + 16 * s, (u32x2){cvt_pk_bf16(v.x, v.y), cvt_pk_bf16(v.z, v.w)});
            if constexpr (ROUTER) { const f32x4 w0 = *(const f32x4*)(w0p + 16 * s), w1 = *(const f32x4*)(w1p + 16 * s);
#pragma unroll
                for (int j = 0; j < 4; ++j) { acc0 = __builtin_amdgcn_mfma_f32_16x16x4f32(v[j], w0[j], acc0, 0, 0, 0); acc1 = __builtin_amdgcn_mfma_f32_16x16x4f32(v[j], w1[j], acc1, 0, 0, 0); } }
        }
        ss += __shfl_xor(ss, 16); ss += __shfl_xor(ss, 32);
        if (kq == 0) pss[wave * 16 + r] = ss;
        if constexpr (ROUTER) {
#pragma unroll
            for (int q = 0; q < 4; ++q) { plg[(wave * 16 + 4 * kq + q) * 32 + r] = acc0[q]; plg[(wave * 16 + 4 * kq + q) * 32 + 16 + r] = acc1[q]; } }
        __syncthreads();
        if (F.tid < 16) { const int t = F.tid, tok = task * 16 + t; float s = 0.f;
#pragma unroll
            for (int w = 0; w < 8; ++w) s += pss[w * 16 + t];
            const float rs = 1.0f / sqrtf(s * (1.0f / DM) + EPS); st_coh(rstd + tok, rs);
            if constexpr (ROUTER) {
                float lg[4];
#pragma unroll
                for (int c = 0; c < 4; ++c) { float q = 0.f;
#pragma unroll
                    for (int w = 0; w < 8; ++w) q += plg[(w * 16 + t) * 32 + c];
                    lg[c] = q * rs + bgroup[c]; }
                int gi = 0; float gm = lg[0];
#pragma unroll
                for (int c = 1; c < 4; ++c) if (lg[c] > gm) { gm = lg[c]; gi = c; }
                float den = 0.f;
#pragma unroll
                for (int c = 0; c < 4; ++c) den += expf(lg[c] - gm);
                const float gval = 1.0f / den;
                float sv[4];
#pragma unroll
                for (int j = 0; j < 4; ++j) { float q = 0.f;
#pragma unroll
                    for (int w = 0; w < 8; ++w) q += plg[(w * 16 + t) * 32 + 4 + 4 * gi + j];
                    sv[j] = q * rs + brouter[4 * gi + j]; }
                int i1 = 0; float v1 = sv[0];
#pragma unroll
                for (int j = 1; j < 4; ++j) if (sv[j] > v1) { v1 = sv[j]; i1 = j; }
                int i2 = -1; float v2 = -3.0e38f;
#pragma unroll
                for (int j = 0; j < 4; ++j) if (j != i1 && sv[j] > v2) { v2 = sv[j]; i2 = j; }
                const float w1 = 1.0f / (1.0f + expf(v2 - v1)), w2 = 1.0f - w1;
                const int e1 = 4 * gi + i1, e2 = 4 * gi + i2;
#ifdef DBG_ROUTE
                { float* dbg = (float*)(F.ws + WS_OB) + (size_t)tok * 4096; for (int q = 0; q < 4096; q += 4) { dbg[q] = (float)e1; dbg[q + 1] = (float)e2; dbg[q + 2] = w1 * gval; dbg[q + 3] = rs; } }
#endif
                const unsigned p1 = __hip_atomic_fetch_add(cnt + e1 * 64, 1u, __ATOMIC_RELAXED, __HIP_MEMORY_SCOPE_AGENT);
                const unsigned p2 = __hip_atomic_fetch_add(cnt + e2 * 64, 1u, __ATOMIC_RELAXED, __HIP_MEMORY_SCOPE_AGENT);
                if (p1 < (unsigned)LISTCAP) { st_coh(list_tok + e1 * LISTCAP + p1, tok * 2); st_coh(list_w + e1 * LISTCAP + p1, w1 * gval); }
                if (p2 < (unsigned)LISTCAP) { st_coh(list_tok + e2 * LISTCAP + p2, tok * 2 + 1); st_coh(list_w + e2 * LISTCAP + p2, w2 * gval); }
            }
        }
        __syncthreads();
    }
}

template <bool DOWN>
__device__ __forceinline__ int build_group(Frame& F, const unsigned* cnt, const int* list_tok, const float* list_w, const float* rstd, int nN, int K2  ) {
    LAS int* ti = (LAS int*)(F.lds + TAB_OFF);
    LAS unsigned* tabA = (LAS unsigned*)(F.lds + TAB_OFF + 256);
    LAS float* tabR = (LAS float*)(F.lds + TAB_OFF + 256 + 8 * 1024);
    LAS float* tabW = (LAS float*)(F.lds + TAB_OFF + 256 + 16 * 1024);
    if (F.tid == 0) {
        int ts = 0;
        for (int e = 0; e < NE; ++e) { ti[8 + e] = ts; const unsigned c = __hip_atomic_load(cnt + e * 64, __ATOMIC_RELAXED, __HIP_MEMORY_SCOPE_AGENT); ts += (int)((c > (unsigned)LISTCAP ? (unsigned)LISTCAP : c) + 255u) >> 8; }
        ti[8 + NE] = ts;
        int n = 0;
        for (int i = 0; n < 8; ++i) { const long L = (long)i * F.G + F.bid; if (L >= (long)ts * nN) break; int pm, pn; pg8::tile_of((int)L, ts, nN, pm, pn);
            int e = 0; while (e < NE - 1 && ti[8 + e + 1] <= pm) ++e;
            ti[32 + 3 * n] = pm; ti[32 + 3 * n + 1] = pn; ti[32 + 3 * n + 2] = e * nN + pn; ++n; }
        ti[0] = n;
    }
    __syncthreads();
    const int n = ti[0];
    for (int i = 0; i < n; ++i) {
        if (F.tid < 256) { const int rr = F.tid, pm = ti[32 + 3 * i], e = ti[32 + 3 * i + 2] / nN, idx = (pm - ti[8 + e]) * 256 + rr;
            unsigned c = __hip_atomic_load(cnt + e * 64, __ATOMIC_RELAXED, __HIP_MEMORY_SCOPE_AGENT); if (c > (unsigned)LISTCAP) c = LISTCAP;
            const bool valid = (unsigned)idx < c;
            int tk = 0; float w = 0.f; if (valid) { tk = ld_coh(list_tok + e * LISTCAP + idx); w = ld_coh(list_w + e * LISTCAP + idx); }
            if constexpr (DOWN) { tabA[i * 256 + rr] = valid ? (unsigned)((tk & 1) * T + (tk >> 1)) : 0xFFFFFFFFu; }
            else { tabA[i * 256 + rr] = (unsigned)(tk >> 1) * (unsigned)K2; tabR[i * 256 + rr] = valid ? ld_coh(rstd + (tk >> 1)) : 0.f; tabW[i * 256 + rr] = w; } }
    }
    __syncthreads();
    return n;
}

__device__ __forceinline__ float gelu_tanh(float y) { const float z = 1.5957691216f * (y + 0.044715f * y * y * y); return y * fast_sigmoid(z); }
struct Cx { float re, im; };
__device__ __forceinline__ Cx cmul(Cx a, Cx b) { return {a.re * b.re - a.im * b.im, a.re * b.im + a.im * b.re}; }
__device__ __forceinline__ Cx cfma(Cx a, Cx b, Cx c) { return {fmaf(a.re, b.re, fmaf(-a.im, b.im, c.re)), fmaf(a.re, b.im, fmaf(a.im, b.re, c.im))}; }
template <int PASS>
__device__ __forceinline__ void scan_task(KArgsPtr a, unsigned char* ws, LAS unsigned char* wlds, int b, int g, int seg, int lane) {
    const int c = lane & 31, hi = lane >> 5; int chkflag = 0; (void)chkflag;
    const bf16_t* ub = (const bf16_t*)(ws + WS_UB); bf16_t* yb = (bf16_t*)(ws + WS_YB); float* ends = (float*)(ws + WS_ENDS);
    const float dt = expf(a->in[4][g]);
    Cx lam[2], lam16[2]; bf16x8 Bre[2], Bim[2];
#pragma unroll
    for (int s = 0; s < 2; ++s) { const int p = c + 32 * s; const float are = a->in[2][g * SP + p], aim = a->in[3][g * SP + p];
        const float mag = expf(are * dt), th = aim * dt; const float lr = mag * __cosf(th), li = mag * __sinf(th);
        lam[s] = {lr, li};
        const float den = are * are + aim * aim, nr = lr - 1.0f; const float qre = (nr * are + li * aim) / den, qim = (li * are - nr * aim) / den;
        const float* brp = a->in[5] + ((size_t)(g * SP + p)) * SJ + 8 * hi; const float* bip = a->in[6] + ((size_t)(g * SP + p)) * SJ + 8 * hi;
        const f32x4 br0 = *(const f32x4*)brp, br1 = *(const f32x4*)(brp + 4), bi0 = *(const f32x4*)bip, bi1 = *(const f32x4*)(bip + 4);
        float vr[8], vi[8];
#pragma unroll
        for (int j = 0; j < 4; ++j) { vr[j] = qre * br0[j] - qim * bi0[j]; vi[j] = qre * bi0[j] + qim * br0[j]; vr[4 + j] = qre * br1[j] - qim * bi1[j]; vi[4 + j] = qre * bi1[j] + qim * br1[j]; }
        u32x4 wr_ = {cvt_pk_bf16(vr[0], vr[1]), cvt_pk_bf16(vr[2], vr[3]), cvt_pk_bf16(vr[4], vr[5]), cvt_pk_bf16(vr[6], vr[7])};
        u32x4 wi_ = {cvt_pk_bf16(vi[0], vi[1]), cvt_pk_bf16(vi[2], vi[3]), cvt_pk_bf16(vi[4], vi[5]), cvt_pk_bf16(vi[6], vi[7])};
        Bre[s] = __builtin_bit_cast(bf16x8, wr_); Bim[s] = __builtin_bit_cast(bf16x8, wi_);
        Cx l2 = cmul(lam[s], lam[s]), l4 = cmul(l2, l2), l8 = cmul(l4, l4); lam16[s] = cmul(l8, l8); }
    Cx carry[2] = {{0.f, 0.f}, {0.f, 0.f}};
    bf16x8 Cf[4]; float dsk = 0.f;
    if constexpr (PASS == 2) {
        Cx lamL[2];
#pragma unroll
        for (int s = 0; s < 2; ++s) { Cx t = lam16[s]; for (int q = 16; q < LSEG; q <<= 1) t = cmul(t, t); lamL[s] = t; }
        for (int sp = 0; sp < seg; ++sp) {
#pragma unroll
            for (int s = 0; s < 2; ++s) { const float* ep = ends + ((size_t)((b * NG + g) * NSEG + sp)) * 128 + 2 * (c + 32 * s); carry[s] = cfma(lamL[s], carry[s], Cx{ld_coh(ep), ld_coh(ep + 1)}); } }
#ifdef DBG_SELFCHK2
        { Cx c2[2] = {{0.f, 0.f}, {0.f, 0.f}};
          for (int sp = 0; sp < seg; ++sp) {
#pragma unroll
            for (int s = 0; s < 2; ++s) { const float* ep = ends + ((size_t)((b * NG + g) * NSEG + sp)) * 128 + 2 * (c + 32 * s); c2[s] = cfma(lamL[s], c2[s], Cx{ld_coh(ep), ld_coh(ep + 1)}); } }
          _Pragma("unroll") for (int s = 0; s < 2; ++s) if (__builtin_bit_cast(unsigned, c2[s].re) != __builtin_bit_cast(unsigned, carry[s].re) || __builtin_bit_cast(unsigned, c2[s].im) != __builtin_bit_cast(unsigned, carry[s].im)) chkflag |= 2; }
#endif
        const int ca = lane & 15, kq = lane >> 4;
#pragma unroll
        for (int ks = 0; ks < 4; ++ks) { const f32x4 cr = *(const f32x4*)(a->in[7] + ((size_t)(g * SJ + ca)) * SP + 16 * ks + 4 * kq), ci = *(const f32x4*)(a->in[8] + ((size_t)(g * SJ + ca)) * SP + 16 * ks + 4 * kq);
            u32x4 w = {cvt_pk_bf16(cr[0], -ci[0]), cvt_pk_bf16(cr[1], -ci[1]), cvt_pk_bf16(cr[2], -ci[2]), cvt_pk_bf16(cr[3], -ci[3])}; Cf[ks] = __builtin_bit_cast(bf16x8, w); }
        dsk = a->in[9][g * SJ + ca];
    }
    const int tl = 16 * ((c >> 2) & 1) + (c & 3) + 4 * (c >> 3);
    LAS unsigned* Xs = (LAS unsigned*)wlds;
    for (int ch = 0; ch < LSEG / 32; ++ch) {
        const int t0 = b * SEQ + seg * LSEG + ch * 32;
        const bf16x8 af = *(const bf16x8*)(ub + (size_t)(t0 + tl) * SW + g * SJ + 8 * hi);
        f32x16 X[2][2];
#pragma unroll
        for (int s = 0; s < 2; ++s) { const f32x16 z = {};
            X[s][0] = __builtin_amdgcn_mfma_f32_32x32x16_bf16(af, Bre[s], z, 0, 0, 0); X[s][1] = __builtin_amdgcn_mfma_f32_32x32x16_bf16(af, Bim[s], z, 0, 0, 0); }
#pragma unroll
        for (int s = 0; s < 2; ++s) {
            Cx x = {0.f, 0.f};
#pragma unroll
            for (int r = 0; r < 16; ++r) { x = cfma(lam[s], x, Cx{X[s][0][r], X[s][1][r]}); X[s][0][r] = x.re; X[s][1][r] = x.im; }
            const Cx eo = {__shfl_xor(x.re, 32), __shfl_xor(x.im, 32)};
            if constexpr (PASS == 1) { const Cx e0 = hi ? eo : x, e1 = hi ? x : eo; carry[s] = cfma(lam16[s], cfma(lam16[s], carry[s], e0), e1); }
            else {
                const Cx cin1 = cfma(lam16[s], carry[s], eo); Cx w = hi ? cin1 : carry[s];
#pragma unroll
                for (int r = 0; r < 16; ++r) { w = cmul(lam[s], w); X[s][0][r] += w.re; X[s][1][r] += w.im; }
                const Cx fin = {X[s][0][15], X[s][1][15]}; const Cx fo = {__shfl_xor(fin.re, 32), __shfl_xor(fin.im, 32)};
                carry[s] = hi ? fin : fo;
#pragma unroll
                for (int r = 0; r < 16; ++r) Xs[(16 * hi + r) * 68 + c + 32 * s] = cvt_pk_bf16(X[s][0][r], X[s][1][r]);
            }
        }
        if constexpr (PASS == 2) {
            LDS_WAIT();
            const int ca = lane & 15, kq = lane >> 4;
#pragma unroll
            for (int rb = 0; rb < 2; ++rb) { f32x4 acc = {0.f, 0.f, 0.f, 0.f}; asm volatile("" : "+v"(acc));
#pragma unroll
                for (int ks = 0; ks < 4; ++ks) { const bf16x8 xf = *(const LAS bf16x8*)(Xs + (16 * rb + ca) * 68 + 16 * ks + 4 * kq); acc = __builtin_amdgcn_mfma_f32_16x16x32_bf16(xf, Cf[ks], acc, 0, 0, 0); }
#ifdef DBG_SELFCHK
                { f32x4 acc2 = {0.f, 0.f, 0.f, 0.f}; asm volatile("" : "+v"(acc2)); LDS_WAIT();
#pragma unroll
                  for (int ks = 0; ks < 4; ++ks) { const bf16x8 xf = *(const LAS bf16x8*)(Xs + (16 * rb + ca) * 68 + 16 * ks + 4 * kq); acc2 = __builtin_amdgcn_mfma_f32_16x16x32_bf16(xf, Cf[ks], acc2, 0, 0, 0); }
                  if (__builtin_bit_cast(unsigned, acc[0]) != __builtin_bit_cast(unsigned, acc2[0]) || __builtin_bit_cast(unsigned, acc[1]) != __builtin_bit_cast(unsigned, acc2[1]) ||
                      __builtin_bit_cast(unsigned, acc[2]) != __builtin_bit_cast(unsigned, acc2[2]) || __builtin_bit_cast(unsigned, acc[3]) != __builtin_bit_cast(unsigned, acc2[3])) chkflag |= 1; }
#endif
#pragma unroll
                for (int q = 0; q < 4; ++q) { const size_t o = (size_t)(t0 + 16 * rb + 4 * kq + q) * SW + g * SJ + ca; const float y = acc[q] + dsk * bf2f(ub[o]); st2_wt(yb + o, f2bf(gelu_tanh(y))); } }
            LDS_WAIT();
        }
    }
#if defined(DBG_SELFCHK) || defined(DBG_SELFCHK2) || defined(DBG_SELFCHK3)
    if constexpr (PASS == 2) { const int any = __any(chkflag != 0); float* dbg = (float*)(ws + WS_OC); if (lane == 0) dbg[(b * NG + g) * NSEG + seg] = any ? 1000.f : 0.f; }
#endif
    if constexpr (PASS == 1) { if (hi == 0) {
#pragma unroll
        for (int s = 0; s < 2; ++s) st8_wt(ends + ((size_t)((b * NG + g) * NSEG + seg)) * 128 + 2 * (c + 32 * s), (u32x2){__builtin_bit_cast(unsigned, carry[s].re), __builtin_bit_cast(unsigned, carry[s].im)}); } }
}
template <int PASS>
__device__ __forceinline__ void scan_phase(Frame& F, KArgsPtr a) {
    const int gw = F.vcu * NWAVES + F.wave, NGW = F.G * NWAVES;
    for (int task = gw; task < BATCH * NG * NSEG; task += NGW) { const int seg = task % NSEG, g = (task / NSEG) % NG, b = task / (NSEG * NG);
        if (PASS == 1 && seg == NSEG - 1) continue;
        scan_task<PASS>(a, F.ws, F.lds + F.wave * 9216, b, g, seg, F.lane); }
}

namespace att {
constexpr int D = 128, PITCH = 4096;
constexpr float SCALE = 0.08838834764831845f;
constexpr float THR = 8.f;
constexpr int NW = 8, QBLK = 32, KVBLK = 64, QB = NW * QBLK;
constexpr int SHM_V = KVBLK * D * 2, SHM_K = KVBLK * D * 2;
constexpr int ATT_LDS = 2 * SHM_V + 2 * SHM_K + NW * 64 * 4;
#define KSWZ(row, colB) ((row) * 256 + ((colB) ^ (((row) & 7) << 4)))
#define SBAR() __builtin_amdgcn_sched_barrier(0)
__device__ __forceinline__ int v_st(int k, int c) { const int kk = (k & ~0xC) | ((k & 4) << 1) | ((k & 8) >> 1); return ((kk >> 3) * 4 + (c >> 5)) * 512 + ((kk & 7) * 32 + (c & 31)) * 2; }
__device__ __forceinline__ int v_rd_base(int lane) { return ((lane & 3) << 3) | (((lane >> 2) & 3) << 6) | (((lane >> 4) & 1) << 5) | (((lane >> 5) & 1) << 8); }
constexpr int v_rd_off(int d0, int ks, int half) { return d0 * 512 + ks * 4096 + half * 2048; }
__device__ __forceinline__ int crow(int r, int hi) { return (r & 3) + 8 * (r >> 2) + 4 * hi; }
__device__ __forceinline__ unsigned cvtpk(float lo, float hi) { unsigned r; asm volatile("v_cvt_pk_bf16_f32 %0, %1, %2" : "=v"(r) : "v"(lo), "v"(hi)); return r; }
__device__ __forceinline__ bf16x8 load8(const bf16_t* p) { return *reinterpret_cast<const bf16x8*>(p); }
__device__ __forceinline__ void mask_tile(f32x16& p0, f32x16& p1, int dq, unsigned W) {
    const float NEG = -__builtin_inff();
#pragma unroll
    for (int r = 0; r < 16; ++r) { const int c = (r & 3) + 8 * (r >> 2);
        if ((unsigned)(dq - c) >= W) p0[r] = NEG;
        if ((unsigned)(dq - c - 32) >= W) p1[r] = NEG; }
}
__device__ __forceinline__ void partialSM(f32x16& p0, f32x16& p1, float& m_reg, float& mn, float& alpha) {
    float pmax = p0[0]; for (int r = 1; r < 16; ++r) pmax = fmaxf(pmax, p0[r]); for (int r = 0; r < 16; ++r) pmax = fmaxf(pmax, p1[r]);
    { auto rr = __builtin_amdgcn_permlane32_swap(__float_as_uint(pmax), __float_as_uint(pmax), false, false);
      pmax = fmaxf(__uint_as_float(rr[0]), __uint_as_float(rr[1])); }
    constexpr float C2 = 1.4426950408889634f * SCALE;
    if (__builtin_expect(__all((pmax - m_reg) * SCALE <= THR), 1)) { mn = m_reg; alpha = 1.f; }
    else { mn = fmaxf(m_reg, pmax); alpha = __builtin_amdgcn_exp2f((m_reg - mn) * C2); m_reg = mn; }
    const float mnL = -mn * C2;
    for (int r = 0; r < 16; ++r) p0[r] = fmaf(p0[r], C2, mnL); for (int r = 0; r < 16; ++r) p1[r] = fmaf(p1[r], C2, mnL);
    for (int r = 0; r < 16; ++r) p0[r] = __builtin_amdgcn_exp2f(p0[r]);
}
__device__ __forceinline__ void finishSM(f32x16& p0, f32x16& p1, float alpha, float& l_reg, bf16x8& pa0, bf16x8& pa1, bf16x8& pa2, bf16x8& pa3) {
    for (int r = 0; r < 16; ++r) p1[r] = __builtin_amdgcn_exp2f(p1[r]);
    float ps = 0; for (int r = 0; r < 16; ++r) ps += p0[r]; for (int r = 0; r < 16; ++r) ps += p1[r];
    { auto rr = __builtin_amdgcn_permlane32_swap(__float_as_uint(ps), __float_as_uint(ps), false, false);
      ps = __uint_as_float(rr[0]) + __uint_as_float(rr[1]); }
    l_reg = l_reg * alpha + ps;
#define PK4(P, B_, OUT) do { unsigned a0 = cvtpk(P[B_+0], P[B_+1]), a1 = cvtpk(P[B_+2], P[B_+3]);                          \
        unsigned b0 = cvtpk(P[B_+4], P[B_+5]), b1 = cvtpk(P[B_+6], P[B_+7]);                                             \
        auto r0 = __builtin_amdgcn_permlane32_swap(a0, b0, false, false); auto r1 = __builtin_amdgcn_permlane32_swap(a1, b1, false, false); \
        u32x4 w = {r0[0], r1[0], r0[1], r1[1]}; OUT = *reinterpret_cast<bf16x8*>(&w); } while (0)
    PK4(p0, 0, pa0); PK4(p0, 8, pa1); PK4(p1, 0, pa2); PK4(p1, 8, pa3);
#undef PK4
}
template <int KB>
__device__ __forceinline__ void qkt(f32x16& p0, f32x16& p1, const char* K_lds, int r32, int hi, const bf16x8* qr, float sl, float tb) {
    { const float sl8 = 8.0f * sl, sl32 = 32.0f * sl;
#pragma unroll
      for (int r = 0; r < 16; ++r) { p0[r] = (r == 0) ? tb : ((r & 3) ? p0[r - 1] + sl : p0[r - 4] + sl8); }
#pragma unroll
      for (int r = 0; r < 16; ++r) p1[r] = p0[r] + sl32; }
    const char* kb[4];
#pragma unroll
    for (int dd = 0; dd < 4; ++dd) kb[dd] = K_lds + KB * SHM_K + KSWZ(r32, (dd * 16 + hi * 8) * 2);
#pragma unroll
    for (int d0 = 0; d0 < 8; ++d0) { const char* a = kb[d0 & 3] + (d0 >> 2) * 128;
        bf16x8 b0 = *reinterpret_cast<const bf16x8*>(a);
        bf16x8 b1 = *reinterpret_cast<const bf16x8*>(a + 32 * 256);
        p0 = __builtin_amdgcn_mfma_f32_32x32x16_bf16(b0, qr[d0], p0, 0, 0, 0);
        p1 = __builtin_amdgcn_mfma_f32_32x32x16_bf16(b1, qr[d0], p1, 0, 0, 0); }
}
template <int VB>
__device__ __forceinline__ void pv_tile(f32x16* o, int vb0, bf16x8 pa0, bf16x8 pa1, bf16x8 pa2, bf16x8 pa3) {
#define TRRD(dst, off) asm volatile("ds_read_b64_tr_b16 %0, %1 offset:%2" : "=&v"(dst) : "v"(vb0), "i"(off) : "memory")
#define PV_D0(d0) do { s16x4 l0, l1, l2, l3, h0, h1, h2, h3; constexpr int b_ = VB * SHM_V + v_rd_off(d0, 0, 0);  \
        TRRD(l0, b_); TRRD(h0, b_ + 2048); TRRD(l1, b_ + 4096); TRRD(h1, b_ + 6144); TRRD(l2, b_ + 8192); TRRD(h2, b_ + 10240); TRRD(l3, b_ + 12288); TRRD(h3, b_ + 14336); \
        asm volatile("s_waitcnt lgkmcnt(0)" ::: "memory"); SBAR();   \
        o[d0] = __builtin_amdgcn_mfma_f32_32x32x16_bf16(pa0, (bf16x8){l0[0], l0[1], l0[2], l0[3], h0[0], h0[1], h0[2], h0[3]}, o[d0], 0, 0, 0);   \
        o[d0] = __builtin_amdgcn_mfma_f32_32x32x16_bf16(pa1, (bf16x8){l1[0], l1[1], l1[2], l1[3], h1[0], h1[1], h1[2], h1[3]}, o[d0], 0, 0, 0);   \
        o[d0] = __builtin_amdgcn_mfma_f32_32x32x16_bf16(pa2, (bf16x8){l2[0], l2[1], l2[2], l2[3], h2[0], h2[1], h2[2], h2[3]}, o[d0], 0, 0, 0);   \
        o[d0] = __builtin_amdgcn_mfma_f32_32x32x16_bf16(pa3, (bf16x8){l3[0], l3[1], l3[2], l3[3], h3[0], h3[1], h3[2], h3[3]}, o[d0], 0, 0, 0); } while (0)
    PV_D0(0); PV_D0(1); PV_D0(2); PV_D0(3);
#undef PV_D0
#undef TRRD
}
struct BlockRef { const bf16_t* Q; const bf16_t* K; const bf16_t* V; bf16_t* O; int P0; float sl; };
struct Seam { bf16x8 qr[8]; bf16x8 st_v0, st_v1, st_k0, st_k1; };
#define ROW(p, k0, rr) ((p) + (size_t)((k0) + (rr)) * PITCH + sc)
#define VMW() asm volatile("s_waitcnt vmcnt(0)" ::: "memory")
#define VMWN(n) asm volatile("s_waitcnt vmcnt(%0)" :: "i"(n) : "memory")
#define SLOAD_H(Kp, Vp, k0) do { S.st_v0 = load8(ROW(Vp, k0, sr)); S.st_v1 = load8(ROW(Vp, k0, 32 + sr));              \
                         S.st_k0 = load8(ROW(Kp, k0, sr)); S.st_k1 = load8(ROW(Kp, k0, 32 + sr)); } while (0)
#define SWRITE_HK(bf) do { *(bf16x8*)(K_lds + (bf) * SHM_K + kws) = S.st_k0; *(bf16x8*)(K_lds + (bf) * SHM_K + kws + 32 * 256) = S.st_k1; } while (0)
#define SWRITE_HV(bf) do { *(bf16x8*)(V_lds + (bf) * SHM_V + vst0) = S.st_v0; *(bf16x8*)(V_lds + (bf) * SHM_V + vst1) = S.st_v1; } while (0)
#define SWRITE_H(bf) do { SWRITE_HV(bf); SWRITE_HK(bf); } while (0)
__device__ __forceinline__ void causal_prime(const BlockRef& cur, char* lds, Seam& S) {
    const int tid = tid_opaque(), wid = __builtin_amdgcn_readfirstlane(tid >> 6), lane = tid & 63, r32 = lane & 31, hi = lane >> 5;
    const int sr = tid >> 4, sc = (tid & 15) * 8, kws = KSWZ(sr, sc * 2); char* K_lds = lds + 2 * SHM_V;
    for (int d0 = 0; d0 < 8; ++d0) S.qr[d0] = load8(cur.Q + (size_t)(wid * QBLK + r32) * PITCH + d0 * 16 + hi * 8);
    SLOAD_H(cur.K, cur.V, 0); VMW(); SWRITE_HK(0);
    __syncthreads();
}
__device__ __forceinline__ void causal_block(const BlockRef& cur, const BlockRef& nxt, char* lds, Seam& S) {
    const int tid = tid_opaque(), wid = __builtin_amdgcn_readfirstlane(tid >> 6), lane = tid & 63, r32 = lane & 31, hi = lane >> 5;
    const int W = SEQ;
    const int j_hi = (cur.P0 + QB - 1) / KVBLK + 1;
    const int NT = j_hi;
    const int qlo = cur.P0 + wid * QBLK, qm = qlo + r32 - 4 * hi;
    char* V_lds = lds; char* K_lds = lds + 2 * SHM_V;
    float* ws = (float*)(lds + 2 * SHM_V + 2 * SHM_K) + wid * 64; float* li_l = ws, * al_l = ws + 32;
    float m_reg = -1e30f, l_reg = 0; f32x16 o[4] = {};
    const int sr = tid >> 4, sc = (tid & 15) * 8, vst0 = v_st(sr, sc), vst1 = v_st(32 + sr, sc), kws = KSWZ(sr, sc * 2);
    const int vb0 = (int)(uintptr_t)V_lds + v_rd_base(lane);
    const bf16_t* Kh = cur.K; const bf16_t* Vh = cur.V;
    const float sl = cur.sl, tb0 = sl * (float)(4 * hi - cur.P0);
#define RESC(a) do { if (__any((a) < 1.f)) { if (hi == 0) al_l[r32] = (a); asm volatile("s_waitcnt lgkmcnt(0)" ::: "memory");              \
                     for (int d_ = 0; d_ < 4; ++d_) for (int r = 0; r < 16; ++r) o[d_][r] *= al_l[crow(r, hi)]; } } while (0)
#define KBASE(t) ((t) * KVBLK)
#define TB(t) fmaf(sl, (float)KBASE(t), tb0)
#define MASKT(P0_, P1_, t) do { const int kb_ = KBASE(t); if (kb_ + KVBLK - 1 > qlo) mask_tile(P0_, P1_, qm - kb_, (unsigned)W); } while (0)
    constexpr int NQL = 8;
#define SEAM_K0() do { VMWN(NQL); SWRITE_HK(0); SBAR(); } while (0)
    f32x16 pA0, pA1, pB0, pB1; float mnA, mnB, alA, alB; bf16x8 pa0, pa1, pa2, pa3;
    SWRITE_HV(0); SBAR();
    if (NT > 1) { SLOAD_H(Kh, Vh, KBASE(1)); }
    SBAR(); qkt<0>(pA0, pA1, K_lds, r32, hi, S.qr, sl, TB(0));
    MASKT(pA0, pA1, 0); partialSM(pA0, pA1, m_reg, mnA, alA);
    if (NT > 1) { VMW(); SWRITE_H(1); }
    __syncthreads();
#define HALF_STEP(PX0, PX1, mnX, alX, PY0, PY1, alY, t, KB, VB, SB) do {                                                      \
        SBAR(); qkt<KB>(PX0, PX1, K_lds, r32, hi, S.qr, sl, TB(t));                                             \
        finishSM(PY0, PY1, alY, l_reg, pa0, pa1, pa2, pa3); SBAR();                                                           \
        if ((t) + 1 < NT) { SLOAD_H(Kh, Vh, KBASE((t) + 1)); SBAR(); }                                               \
        pv_tile<VB>(o, vb0, pa0, pa1, pa2, pa3); MASKT(PX0, PX1, (t)); partialSM(PX0, PX1, m_reg, mnX, alX);                                        \
        __syncthreads();                                                                                                      \
        if ((t) + 1 < NT) { VMW(); SWRITE_H(SB); }                                                                          \
        RESC(alX); __syncthreads(); } while (0)
    for (int t = 1; t + 1 < NT; t += 2) {
        HALF_STEP(pB0, pB1, mnB, alB, pA0, pA1, alA, t, 1, 0, 0);
        HALF_STEP(pA0, pA1, mnA, alA, pB0, pB1, alB, t + 1, 0, 1, 1);
    }
    const bool even = (NT & 1) == 0;
    if (even) { SBAR(); qkt<1>(pB0, pB1, K_lds, r32, hi, S.qr, sl, TB(NT - 1)); SBAR(); }
    SLOAD_H(nxt.K, nxt.V, 0); SBAR();
#pragma unroll
    for (int d0 = 0; d0 < 8; ++d0) S.qr[d0] = load8(nxt.Q + (size_t)(wid * QBLK + r32) * PITCH + d0 * 16 + hi * 8);
    SBAR();
    finishSM(pA0, pA1, alA, l_reg, pa0, pa1, pa2, pa3); SBAR();
    pv_tile<0>(o, vb0, pa0, pa1, pa2, pa3);
    if (even) { MASKT(pB0, pB1, NT - 1); partialSM(pB0, pB1, m_reg, mnB, alB); __syncthreads(); RESC(alB);
        finishSM(pB0, pB1, alB, l_reg, pa0, pa1, pa2, pa3); SBAR(); pv_tile<1>(o, vb0, pa0, pa1, pa2, pa3); }
    SBAR(); SEAM_K0();
    if (hi == 0) li_l[r32] = l_reg; asm volatile("s_waitcnt lgkmcnt(0)" ::: "memory");
    float rli[16];
#pragma unroll
    for (int r = 0; r < 16; ++r) rli[r] = __builtin_amdgcn_rcpf(li_l[crow(r, hi)]);
    bf16_t* Ow = cur.O + (size_t)(wid * QBLK) * PITCH;
#pragma unroll
    for (int r = 0; r < 16; ++r) { const int orow = crow(r, hi);
#pragma unroll
        for (int d0 = 0; d0 < 4; ++d0) { const float v = o[d0][r] * rli[r];
            const float vn = __shfl_xor(v, 1);
            if ((r32 & 1) == 0) st4_wt(Ow + (size_t)orow * PITCH + d0 * 32 + r32, cvtpk(v, vn)); } }
    __syncthreads();
#undef RESC
#undef KBASE
#undef TB
#undef MASKT
#undef SEAM_K0
#undef HALF_STEP
}
#undef ROW
#undef VMW
#undef VMWN
#undef SLOAD_H
#undef SWRITE_HK
#undef SWRITE_HV
#undef SWRITE_H
#undef KSWZ
#undef SBAR
__device__ __forceinline__ BlockRef make_ref(unsigned char* ws, int hp, int qb) {
    const int vh = hp & 1, c = (hp >> 1) & 1, h = (hp >> 2) & 15, b = hp >> 6;
    const bf16_t* Q = (const bf16_t*)(ws + WS_Q); const bf16_t* Kp = Q + (size_t)T * AW; const bf16_t* Vp = Kp + (size_t)T * AW; bf16_t* O = (bf16_t*)(ws + WS_OC) + (size_t)c * T * AW;
    BlockRef r; const size_t tok0 = (size_t)b * SEQ;
    r.Q = Q + (tok0 + (size_t)qb * QB) * PITCH + h * 256 + c * 128; r.K = Kp + tok0 * PITCH + h * 256 + c * 128; r.V = Vp + tok0 * PITCH + h * 256 + vh * 128;
    r.O = O + (tok0 + (size_t)qb * QB) * PITCH + h * 256 + vh * 128; r.P0 = qb * QB;
    r.sl = exp2f(-0.5f * (float)(h + 1)) * (1.0f / SCALE);
    return r;
}
__device__ __forceinline__ void attn_phase(unsigned char* ws, char* lds, int G, int bid) {
    constexpr int NQB = SEQ / QB, NX = NQB / 2, TOTAL = NX * 128;
    int L = bid; if (L >= TOTAL) return;
    int pass = 0;
    BlockRef cur = make_ref(ws, L / NX, L % NX);
    Seam S;
    causal_prime(cur, lds, S);
    for (;;) {
        const bool more_pass = pass == 0, more_item = L + G < TOTAL, last = !more_pass && !more_item;
        int Ln = L, passn = pass + 1;
        if (!more_pass) { passn = 0; Ln = more_item ? L + G : L; }
        const int xq = Ln % NX; const BlockRef nxt = last ? cur : make_ref(ws, Ln / NX, passn ? NQB - 1 - xq : xq);
        causal_block(cur, nxt, lds, S);
        if (last) break;
        cur = nxt; pass = passn; L = Ln;
    }
}
}

__device__ __forceinline__ void diff_phase(Frame& F, KArgsPtr a) {
    const int lane = F.lane, gw = F.vcu * NWAVES + F.wave, NGW = F.G * NWAVES;
    float d1 = a->in[16][lane] * a->in[17][lane] + a->in[16][lane + 64] * a->in[17][lane + 64];
    float d2 = a->in[18][lane] * a->in[19][lane] + a->in[18][lane + 64] * a->in[19][lane + 64];
    const float lam = expf(wave_sum(d1)) - expf(wave_sum(d2)) + LAMBDA_INIT1;
    const bf16_t* O0 = (const bf16_t*)(F.ws + WS_OC); const bf16_t* O1 = O0 + (size_t)T * AW; bf16_t* ob = (bf16_t*)(F.ws + WS_OB);
    for (int m = gw; m < T; m += NGW) {
        const size_t base = (size_t)m * AW + 64 * lane; float v[64]; float ss = 0.f;
#pragma unroll
        for (int j = 0; j < 8; ++j) { const u32x4 x0 = *(const u32x4*)(O0 + base + 8 * j), x1 = *(const u32x4*)(O1 + base + 8 * j);
#pragma unroll
            for (int q = 0; q < 4; ++q) { const float lo = bf2f(x0[q] & 0xffffu) - lam * bf2f(x1[q] & 0xffffu), hi2 = bf2f(x0[q] >> 16) - lam * bf2f(x1[q] >> 16);
                v[8 * j + 2 * q] = lo; v[8 * j + 2 * q + 1] = hi2; ss += lo * lo + hi2 * hi2; } }
        ss += __shfl_xor(ss, 1); ss += __shfl_xor(ss, 2);
        const float rs = 1.0f / sqrtf(ss * (1.0f / 256.0f) + EPS);
#pragma unroll
        for (int j = 0; j < 8; ++j) { u32x4 w; w.x = cvt_pk_bf16(v[8 * j] * rs, v[8 * j + 1] * rs); w.y = cvt_pk_bf16(v[8 * j + 2] * rs, v[8 * j + 3] * rs);
            w.z = cvt_pk_bf16(v[8 * j + 4] * rs, v[8 * j + 5] * rs); w.w = cvt_pk_bf16(v[8 * j + 6] * rs, v[8 * j + 7] * rs); st16_wt(ob + base + 8 * j, w); }
    }
}
__device__ __forceinline__ void final_phase(Frame& F, KArgsPtr a) {
    const int lane = F.lane, gw = F.vcu * NWAVES + F.wave, NGW = F.G * NWAVES;
    const float* H = (const float*)(F.ws + WS_H); const bf16_t* Y = (const bf16_t*)(F.ws + WS_YS); const float* g = a->in[31];
    for (int m = gw; m < T; m += NGW) {
        const size_t base = (size_t)m * DM + 4 * lane; f32x4 v[16]; float ss = 0.f;
#pragma unroll
        for (int j = 0; j < 16; ++j) { f32x4 x = *(const f32x4*)(H + base + 256 * j); const u32x2 ya = *(const u32x2*)(Y + base + 256 * j), yb2 = *(const u32x2*)(Y + (size_t)T * DM + base + 256 * j);
            x.x += bf2f(ya.x & 0xffffu) + bf2f(yb2.x & 0xffffu); x.y += bf2f(ya.x >> 16) + bf2f(yb2.x >> 16); x.z += bf2f(ya.y & 0xffffu) + bf2f(yb2.y & 0xffffu); x.w += bf2f(ya.y >> 16) + bf2f(yb2.y >> 16);
            v[j] = x; ss += (x.x * x.x + x.y * x.y) + (x.z * x.z + x.w * x.w); }
        const float rs = 1.0f / sqrtf(wave_sum(ss) * (1.0f / DM) + EPS);
#pragma unroll
        for (int j = 0; j < 16; ++j) { const f32x4 gg = *(const f32x4*)(g + 4 * lane + 256 * j); *(f32x4*)(a->out + base + 256 * j) = v[j] * rs * gg; }
    }
}

constexpr int NPHASE = 17;
#ifndef DBG_ROW_WORDS
#define DBG_ROW_WORDS 1024
#endif
#ifndef DBG_COL_LO
#define DBG_COL_LO 0
#define DBG_COL_HI 4096
#endif
#ifndef PHASE_MASK
#define PHASE_MASK 0x1FFFF
#endif
#define PH_BEGIN KArgsPtr a = launder_args(kp); Frame F = make_frame(a, lds); unsigned char* ws = F.ws; (void)ws; (void)F;
__device__ __forceinline__ void ph_u_gemm(KArgsPtr kp, LAS unsigned char* lds) { PH_BEGIN
    pg8::StaticOrder S; S.init(T, SW, F.G, F.bid);
    pg8::EpiRowScaleBf16 E{(bf16_t*)(ws + WS_UB), SW, (const float*)(ws + WS_RSTD), 0, 0};
    pg8::gemm_phase<pg8::EpiRowScaleBf16, pg8::StaticOrder, false>(lds, (const bf16_t*)(ws + WS_XB), (const bf16_t*)(ws + WS_WIN), DM, S, E, nullptr); }
__device__ __forceinline__ void ph_glu_gemm(KArgsPtr kp, LAS unsigned char* lds) { PH_BEGIN
    pg8::StaticOrder S; S.init(T, 2 * DM, F.G, F.bid);
    pg8::EpiGlu E{a->in[0], (float*)(ws + WS_H)};
    pg8::gemm_phase<pg8::EpiGlu, pg8::StaticOrder, false>(lds, (const bf16_t*)(ws + WS_YB), (const bf16_t*)(ws + WS_GLU), SW, S, E, nullptr); }
__device__ __forceinline__ void ph_qkv_gemm(KArgsPtr kp, LAS unsigned char* lds) { PH_BEGIN
    pg8::StaticOrder S; S.init(T, 3 * AW, F.G, F.bid);
    pg8::EpiRowScaleBf16 E{(bf16_t*)(ws + WS_Q), AW, (const float*)(ws + WS_RSTD), AW, (size_t)T * AW};
    pg8::gemm_phase<pg8::EpiRowScaleBf16, pg8::StaticOrder, false>(lds, (const bf16_t*)(ws + WS_XB), (const bf16_t*)(ws + WS_QKV), DM, S, E, nullptr); }
__device__ __forceinline__ void ph_wo_gemm(KArgsPtr kp, LAS unsigned char* lds) { PH_BEGIN
    pg8::StaticOrder S; S.init(T, DM, F.G, F.bid);
    pg8::EpiResAdd E{(float*)(ws + WS_H)};
    pg8::gemm_phase<pg8::EpiResAdd, pg8::StaticOrder, false>(lds, (const bf16_t*)(ws + WS_OB), (const bf16_t*)(ws + WS_WO), AW, S, E, nullptr); }
__device__ __forceinline__ void ph_router(KArgsPtr kp, LAS unsigned char* lds, int li) { PH_BEGIN
    rn_phase<false, true>(F, (float*)(ws + WS_H), nullptr, (bf16_t*)(ws + WS_XB), (float*)(ws + WS_RSTD), (const float*)(ws + WS_WRT) + (size_t)li * 32 * DM, a->in[23] + li * 4, a->in[25] + li * NE,
                          F.ctl + CW_CNT + li * NE * 64, (int*)(ws + WS_LIST), (float*)(ws + WS_LIST + 512 * 1024)); }
__device__ __forceinline__ void ph_combine(KArgsPtr kp, LAS unsigned char* lds) { PH_BEGIN
    rn_phase<true, false>(F, (float*)(ws + WS_H), (const bf16_t*)(ws + WS_YS), (bf16_t*)(ws + WS_XB), (float*)(ws + WS_RSTD), nullptr, nullptr, nullptr, nullptr, nullptr, nullptr); }
__device__ __forceinline__ void ph_gateup(KArgsPtr kp, LAS unsigned char* lds, int li) { PH_BEGIN
    const int n = build_group<false>(F, F.ctl + CW_CNT + li * NE * 64, (const int*)(ws + WS_LIST), (const float*)(ws + WS_LIST + 512 * 1024), (const float*)(ws + WS_RSTD), 8, DM * 2);
    pg8::ListOrder S{(const LAS int*)(lds + TAB_OFF + 128), n};
    pg8::EpiGateUp E{(bf16_t*)(ws + WS_HM), (const LAS float*)(lds + TAB_OFF + 256 + 8 * 1024), (const LAS float*)(lds + TAB_OFF + 256 + 16 * 1024)};
    pg8::gemm_phase<pg8::EpiGateUp, pg8::ListOrder, true>(lds, (const bf16_t*)(ws + WS_XB), (const bf16_t*)(ws + WS_GU) + (size_t)li * NE * 2048 * DM, DM, S, E, (const LAS unsigned*)(lds + TAB_OFF + 256)); }
__device__ __forceinline__ void ph_down(KArgsPtr kp, LAS unsigned char* lds, int li) { PH_BEGIN
    const int n = build_group<true>(F, F.ctl + CW_CNT + li * NE * 64, (const int*)(ws + WS_LIST), (const float*)(ws + WS_LIST + 512 * 1024), (const float*)(ws + WS_RSTD), 16, 0);
    pg8::ListOrder S{(const LAS int*)(lds + TAB_OFF + 128), n};
    pg8::EpiDown E{(bf16_t*)(ws + WS_YS), (const LAS unsigned*)(lds + TAB_OFF + 256)};
    pg8::gemm_phase<pg8::EpiDown, pg8::ListOrder, false>(lds, (const bf16_t*)(ws + WS_HM), (const bf16_t*)(ws + WS_DN) + (size_t)li * NE * DM * FF, FF, S, E, nullptr); }
__device__ __forceinline__ void ph_prologue(KArgsPtr kp, LAS unsigned char* lds) { PH_BEGIN p0_prologue(F, a); }
__device__ __forceinline__ void ph_scan1(KArgsPtr kp, LAS unsigned char* lds) { PH_BEGIN
    scan_phase<1>(F, a); }
__device__ __forceinline__ void ph_scan2(KArgsPtr kp, LAS unsigned char* lds) { PH_BEGIN scan_phase<2>(F, a); }
__device__ __forceinline__ void ph_attn(KArgsPtr kp, LAS unsigned char* lds) { PH_BEGIN att::attn_phase(ws, (char*)lds, F.G, F.bid); }
__device__ __forceinline__ void ph_diff(KArgsPtr kp, LAS unsigned char* lds) { PH_BEGIN diff_phase(F, a); }
__device__ __forceinline__ void ph_final(KArgsPtr kp, LAS unsigned char* lds) { PH_BEGIN final_phase(F, a); }

__device__ __forceinline__ void ph_debug(KArgsPtr kp0, LAS unsigned char* lds) {
    KArgsPtr kp = launder_args(kp0);

        XcdBarrier b; b.bar = (unsigned*)(kp->ws + WS_CTL) + CW_BAR; b.x = xb_xcc_id(); b.st = (volatile LAS unsigned*)(lds + MISC_OFF) + 8; xcd_barrier(b);
        const int dtid = tid_opaque(), dbid = bid_opaque(), dgrid = grid_opaque();
        if (kp->dbg_kind == 12) { const float* dbg = (const float*)(kp->ws + WS_OC); float* o12 = kp->out; _Pragma("nounroll") for (size_t i = (size_t)dbid * 512 + dtid; i < (size_t)T * DM; i += (size_t)dgrid * 512) o12[i] = dbg[i & 2047]; return; }
        if (kp->dbg_kind == 10) {
            const int lane = dtid & 63, gw = dbid * 8 + (dtid >> 6), ngw = dgrid * 8; float* o10 = kp->out;
            _Pragma("nounroll") for (int r = gw; r < T; r += ngw) { const unsigned* p = (const unsigned*)(kp->ws + kp->dbg_off) + (size_t)r * DBG_ROW_WORDS; unsigned c = 0;
                _Pragma("nounroll") for (int j = lane; j < DBG_ROW_WORDS; j += 64) { const unsigned w = p[j]; c += (w ^ (w >> 16)) * 2654435761u; c = (c << 5) | (c >> 27); }
                for (int off2 = 1; off2 < 64; off2 <<= 1) c += __shfl_xor(c, off2);
                const float v = (float)(c & 0xFFFFu);
                _Pragma("nounroll") for (int j = lane; j < DM; j += 64) o10[(size_t)r * DM + j] = v; }
            return; }
        const size_t n = (size_t)T * DM; float* o = kp->out;
        _Pragma("nounroll") for (size_t i = (size_t)dbid * 512 + dtid; i < n; i += (size_t)dgrid * 512) {
            if (kp->dbg_kind == 9) { o[i] = (float)(((const unsigned*)kp->in[0])[i] & 0xFFFFu); }
            else if (kp->dbg_kind == 7) { o[i] = (float)(((const unsigned*)(kp->ws + kp->dbg_off))[i] & 0xFFFFu); }
            else if (kp->dbg_kind == 6) { o[i] = ((const float*)(kp->ws + WS_H))[i] - kp->in[0][i]; }
            else if (kp->dbg_kind == 5) { const bf16_t* q = (const bf16_t*)(kp->ws + WS_Q); o[i] = bf2f(q[i]) + 2.f * bf2f(q[i + n]) + 4.f * bf2f(q[i + 2 * n]); }
            else if (kp->dbg_kind == 4) { const int col = (int)(i % DM); o[i] = (col >= DBG_COL_LO && col < DBG_COL_HI) ? bf2f(((const bf16_t*)(kp->ws + kp->dbg_off))[i]) : 0.f; }
            else if (kp->dbg_kind == 1) o[i] = bf2f(((const bf16_t*)(kp->ws + kp->dbg_off))[i]); else o[i] = ((const float*)(kp->ws + kp->dbg_off))[i]; }

}
__device__ __forceinline__ bool ph_in(KArgsPtr kp, int k) { asm volatile("" : "+s"(kp)); return kp->ph_lo <= k && k < kp->ph_hi; }
__device__ __forceinline__ void ph_seam(KArgsPtr kp, LAS unsigned char* lds, int k) {
    asm volatile("" : "+s"(kp));
    if (kp->ph_lo <= k && k + 1 < kp->ph_hi) { XcdBarrier b; b.bar = (unsigned*)(kp->ws + WS_CTL) + CW_BAR; b.x = xb_xcc_id(); b.st = (volatile LAS unsigned*)(lds + MISC_OFF) + 8; xcd_barrier(b);
#ifdef DOUBLE_BARRIER
        for (int extra = 1; extra < DOUBLE_BARRIER; ++extra) xcd_barrier(b);
#endif
    }
}
__global__ void __launch_bounds__(NWAVES * 64, 2) yoco_fwd(Args args) {
    extern __shared__ __attribute__((aligned(16))) unsigned char lds_raw[];
    LAS unsigned char* lds = (LAS unsigned char*)lds_raw;
    KArgsPtr kp = (KArgsPtr)__builtin_amdgcn_kernarg_segment_ptr();
#ifdef DBG_DELAY_TICKS
    { const unsigned long long t0 = __builtin_amdgcn_s_memrealtime(); while (__builtin_amdgcn_s_memrealtime() - t0 < (unsigned long long)DBG_DELAY_TICKS) __builtin_amdgcn_s_sleep(10); }
#endif
    { volatile LAS unsigned* MISC = (volatile LAS unsigned*)(lds + MISC_OFF);
      if (threadIdx.x < 64) MISC[threadIdx.x] = 0u;
      __syncthreads();
      (void)xcd_barrier_post((unsigned*)(args.ws + WS_CTL) + CW_BAR, MISC + 8); }
#define IN(k) (((PHASE_MASK >> ((k) & 31)) & 1) && ph_in(kp, (k)))
#define SEAM(k) ph_seam(kp, lds, (k))
    if (IN(0)) ph_prologue(kp, lds); SEAM(0);
    if (IN(1)) ph_u_gemm(kp, lds); SEAM(1);
    if (IN(2)) ph_scan1(kp, lds); SEAM(2);
    if (IN(3)) ph_scan2(kp, lds); SEAM(3);
    if (IN(4)) ph_glu_gemm(kp, lds); SEAM(4);
    if (IN(5)) ph_router(kp, lds, 0); SEAM(5);
    if (IN(6)) ph_gateup(kp, lds, 0); SEAM(6);
    if (IN(7)) ph_down(kp, lds, 0); SEAM(7);
    if (IN(8)) ph_combine(kp, lds); SEAM(8);
    if (IN(9)) ph_qkv_gemm(kp, lds); SEAM(9);
    if (IN(10)) ph_attn(kp, lds); SEAM(10);
    if (IN(11)) ph_diff(kp, lds); SEAM(11);
    if (IN(12)) ph_wo_gemm(kp, lds); SEAM(12);
    if (IN(13)) ph_router(kp, lds, 1); SEAM(13);
    if (IN(14)) ph_gateup(kp, lds, 1); SEAM(14);
    if (IN(15)) ph_down(kp, lds, 1); SEAM(15);
    if (IN(16)) ph_final(kp, lds);
    if (kp->dbg_kind) ph_debug(kp, lds);
#undef IN
#undef SEAM
}

#ifndef MK_N_LAUNCHES
#define MK_N_LAUNCHES 1
#endif
extern "C" void kernel_launch(void* const* d_in, const int* in_sizes, int n_in, void* d_out, int out_size, void* d_ws, size_t ws_size, hipStream_t stream) {
    static int grid = 0;
    if (grid == 0) {
        if (n_in != 32 || out_size != T * DM || ws_size < WS_END) { fprintf(stderr, "kernel_launch: unexpected shapes (n_in %d out %d ws %zu)\n", n_in, out_size, ws_size); grid = -1; return; }
        int dev = 0, cus = 0, per_cu = 0;
        if (hipGetDevice(&dev) != hipSuccess || hipDeviceGetAttribute(&cus, hipDeviceAttributeMultiprocessorCount, dev) != hipSuccess) { grid = -1; return; }
        if (hipFuncSetAttribute((const void*)yoco_fwd, hipFuncAttributeMaxDynamicSharedMemorySize, LDS_BYTES) != hipSuccess) { fprintf(stderr, "kernel_launch: hipFuncSetAttribute failed\n"); grid = -1; return; }
        if (hipOccupancyMaxActiveBlocksPerMultiprocessor(&per_cu, (const void*)yoco_fwd, NWAVES * 64, LDS_BYTES) != hipSuccess || per_cu < 1) fprintf(stderr, "kernel_launch: occupancy query says %d\n", per_cu);
        (void)hipGetLastError();
        grid = cus;
    }
    if (grid < 0) return;
    (void)hipMemsetAsync((char*)d_ws + WS_CTL, 0, CTL_ZERO_BYTES, stream);
#ifdef DBG_ZERO_YS
    (void)hipMemsetAsync((char*)d_ws + WS_YS, 0, (size_t)2 * T * DM * 2, stream);
#endif
    Args a{};
    for (int i = 0; i < 32; ++i) a.in[i] = (const float*)d_in[i];
    a.out = (float*)d_out; a.ws = (unsigned char*)d_ws;
#ifdef DBG_STOP
    a.ph_lo = 0; a.ph_hi = DBG_STOP + 1; a.dbg_kind = DBG_KIND; a.dbg_off = (size_t)DBG_OFF_MIB * MiB;
    hipLaunchKernelGGL(yoco_fwd, dim3(grid), dim3(NWAVES * 64), LDS_BYTES, stream, a);
#elif MK_N_LAUNCHES == 1
    a.ph_lo = 0; a.ph_hi = NPHASE;
    hipLaunchKernelGGL(yoco_fwd, dim3(grid), dim3(NWAVES * 64), LDS_BYTES, stream, a);
#else
    for (int p = 0; p < NPHASE; ++p) { a.ph_lo = p; a.ph_hi = p + 1; hipLaunchKernelGGL(yoco_fwd, dim3(grid), dim3(NWAVES * 64), LDS_BYTES, stream, a); }
#endif
}
```

```cpp
#include <hip/hip_runtime.h>
#include <cstdio>
#include <cstdint>

#define LAS __attribute__((address_space(3)))
#define GAS __attribute__((address_space(1)))
typedef unsigned short bf16_t;
typedef short bf16x8 __attribute__((ext_vector_type(8)));
typedef short s16x4 __attribute__((ext_vector_type(4)));
typedef float f32x4 __attribute__((ext_vector_type(4)));
typedef float f32x2 __attribute__((ext_vector_type(2)));
typedef float f32x16 __attribute__((ext_vector_type(16)));
typedef unsigned u32x4 __attribute__((ext_vector_type(4)));
typedef unsigned u32x2 __attribute__((ext_vector_type(2)));

constexpr int BATCH = 2, SEQ = 4096, T = BATCH * SEQ, DM = 4096;
constexpr int SW = 2048, NG = 128, SJ = 16, SP = 64;
constexpr int NH = 16, HD = 128, AW = 4096;
constexpr int NE = 16, FF = 1024;
constexpr float EPS = 1e-6f;
constexpr float LAMBDA_INIT1 = 0.35550906759f;
constexpr int NSEG = 8, LSEG = SEQ / NSEG;

constexpr size_t MiB = 1u << 20;
constexpr size_t WS_CTL = 0, CTL_ZERO_BYTES = 1 * MiB;
constexpr size_t WS_WIN = 16 * MiB;
constexpr size_t WS_GLU = 32 * MiB;
constexpr size_t WS_QKV = 64 * MiB;
constexpr size_t WS_WO = 160 * MiB;
constexpr size_t WS_GU = 192 * MiB;
constexpr size_t WS_DN = 704 * MiB;
constexpr size_t WS_WRT = 960 * MiB;
constexpr size_t WS_RSTD = 961 * MiB;
constexpr size_t WS_LIST = 962 * MiB;
constexpr size_t WS_ENDS = 963 * MiB;
constexpr size_t WS_XB = 964 * MiB;
constexpr size_t WS_UB = 1028 * MiB;
constexpr size_t WS_YB = 1060 * MiB;
constexpr size_t WS_H = 1092 * MiB;
constexpr size_t WS_Q = 1220 * MiB;
constexpr size_t WS_OC = 1412 * MiB;
constexpr size_t WS_OB = 1540 * MiB;
constexpr size_t WS_YS = 1604 * MiB;
constexpr size_t WS_HM = 1732 * MiB;
constexpr size_t WS_END = 1772 * MiB;
constexpr int CW_BAR = 4096;
constexpr int CW_CNT = 16384;
constexpr int CW_NRM = 20480;
constexpr int LISTCAP = 8192;

constexpr int RING_BYTES = 131072;
constexpr int MISC_OFF = RING_BYTES;
constexpr int TAB_OFF = RING_BYTES + 256;
constexpr int LDS_BYTES = 163840;
constexpr int NWAVES = 8;

#define LDS_WAIT() asm volatile("s_waitcnt lgkmcnt(0)" ::: "memory")
#define VM_WAIT() asm volatile("s_waitcnt vmcnt(0)" ::: "memory")
__device__ __forceinline__ unsigned f2bf(float f) { unsigned u = __builtin_bit_cast(unsigned, f); return (u + 0x7fffu + ((u >> 16) & 1u)) >> 16; }
__device__ __forceinline__ float bf2f(unsigned b) { return __builtin_bit_cast(float, b << 16); }
__device__ __forceinline__ unsigned cvt_pk_bf16(float lo, float hi) { unsigned r; asm volatile("v_cvt_pk_bf16_f32 %0, %1, %2" : "=v"(r) : "v"(lo), "v"(hi)); return r; }
__device__ __forceinline__ float wave_sum(float v) {
#pragma unroll
    for (int o = 1; o < 64; o <<= 1) v += __shfl_xor(v, o);
    return v;
}
__device__ __forceinline__ int tid_opaque() { int t = threadIdx.x; asm volatile("" : "+v"(t)); return t; }
__device__ __forceinline__ int bid_opaque() { int b = blockIdx.x; asm volatile("" : "+s"(b)); return b; }
__device__ __forceinline__ int grid_opaque() { int g = gridDim.x; asm volatile("" : "+s"(g)); return g; }
__device__ __forceinline__ float ld_coh(const float* p) { return __builtin_bit_cast(float, __hip_atomic_load((const unsigned*)p, __ATOMIC_RELAXED, __HIP_MEMORY_SCOPE_AGENT)); }
__device__ __forceinline__ int ld_coh(const int* p) { return (int)__hip_atomic_load((const unsigned*)p, __ATOMIC_RELAXED, __HIP_MEMORY_SCOPE_AGENT); }
__device__ __forceinline__ void st_coh(float* p, float v) { __hip_atomic_store((unsigned*)p, __builtin_bit_cast(unsigned, v), __ATOMIC_RELAXED, __HIP_MEMORY_SCOPE_AGENT); }
__device__ __forceinline__ void st_coh(int* p, int v) { __hip_atomic_store((unsigned*)p, (unsigned)v, __ATOMIC_RELAXED, __HIP_MEMORY_SCOPE_AGENT); }
#ifndef WT_STORES
#define WT_STORES 1
#endif
#if WT_STORES
__device__ __forceinline__ void st16_wt(void* p, u32x4 v) { asm volatile("global_store_dwordx4 %0, %1, off sc1\n\ts_nop 1" :: "v"(p), "v"(v) : "memory"); }
__device__ __forceinline__ void st8_wt(void* p, u32x2 v) { asm volatile("global_store_dwordx2 %0, %1, off sc1\n\ts_nop 1" :: "v"(p), "v"(v) : "memory"); }
__device__ __forceinline__ void st4_wt(void* p, unsigned v) { asm volatile("global_store_dword %0, %1, off sc1\n\ts_nop 1" :: "v"(p), "v"(v) : "memory"); }
__device__ __forceinline__ void st2_wt(void* p, unsigned v) { asm volatile("global_store_short %0, %1, off sc1\n\ts_nop 1" :: "v"(p), "v"(v) : "memory"); }
#else
__device__ __forceinline__ void st16_wt(void* p, u32x4 v) { *(u32x4*)p = v; }
__device__ __forceinline__ void st8_wt(void* p, u32x2 v) { *(u32x2*)p = v; }
__device__ __forceinline__ void st4_wt(void* p, unsigned v) { *(unsigned*)p = v; }
__device__ __forceinline__ void st2_wt(void* p, unsigned v) { *(unsigned short*)p = (unsigned short)v; }
#endif
__device__ __forceinline__ void st16_wt(void* p, f32x4 v) { st16_wt(p, __builtin_bit_cast(u32x4, v)); }
__device__ __forceinline__ float fast_sigmoid(float x) { return __builtin_amdgcn_rcpf(1.0f + __expf(-x)); }

#define XB_TMO      128
#define XB_XCNT(j)  (256  + 64 * (j))
#define XB_XSUB(j)  (1280 + 64 * (j))
#define XB_XGEN(j)  (2304 + 64 * (j))
#define XB_TOP      3328
#define XB_TOPGEN   3392
#define XCD_BAR_WORDS 3456
#define XB_SPIN_CAP (1u << 18)
__device__ __forceinline__ unsigned xb_ld(unsigned* p)              { return __hip_atomic_load(p, __ATOMIC_RELAXED, __HIP_MEMORY_SCOPE_AGENT); }
__device__ __forceinline__ unsigned xb_add(unsigned* p, unsigned v) { return __hip_atomic_fetch_add(p, v, __ATOMIC_RELAXED, __HIP_MEMORY_SCOPE_AGENT); }
__device__ __forceinline__ unsigned xb_xcc_id() { return (unsigned)__builtin_amdgcn_s_getreg((3 << 11) | 20) & 0xFu; }
#define XB_SPIN(cond, bar) do { unsigned _sp = 0; while (cond) { __builtin_amdgcn_s_sleep(1); \
    if ((++_sp & 255u) == 0u) { if (xb_ld(&(bar)[XB_TMO])) break; if (_sp > XB_SPIN_CAP) { atomicAdd(&(bar)[XB_TMO], 1u); break; } } } } while (0)
struct XcdBarrier { unsigned* bar; unsigned x; volatile LAS unsigned* st; };
__device__ __forceinline__ XcdBarrier xcd_barrier_post(unsigned* bar, volatile LAS unsigned* st) {
    XcdBarrier b; b.bar = bar; b.x = xb_xcc_id(); b.st = st;
    if (threadIdx.x == 0) (void)xb_add(&bar[XB_XCNT(b.x)], 1u);
    return b;
}
__device__ __forceinline__ void xcd_barrier_complete(unsigned* bar, unsigned x, unsigned& nloc, unsigned& nx) {
    const unsigned G = gridDim.x * gridDim.y * gridDim.z;
    unsigned sum, cnt, mine, sp = 0u;
    for (;;) {
        sum = 0u; cnt = 0u; mine = 0u;
#pragma unroll
        for (unsigned j = 0; j < 16; ++j) { const unsigned c = xb_ld(&bar[XB_XCNT(j)]); sum += c; cnt += (c > 0u) ? 1u : 0u; mine = (j == x) ? c : mine; }
        if (sum == G) break;
        __builtin_amdgcn_s_sleep(1);
        if ((++sp & 255u) == 0u) { if (xb_ld(&bar[XB_TMO])) break; if (sp > XB_SPIN_CAP) { atomicAdd(&bar[XB_TMO], 1u); break; } }
    }
    nloc = mine > 0u ? mine : 1u; nx = cnt > 0u ? cnt : 1u;
}
__device__ __forceinline__ void xcd_barrier(const XcdBarrier& b) {
    asm volatile("s_waitcnt vmcnt(0)" ::: "memory");
    __syncthreads();
    if (threadIdx.x == 0) {
        unsigned* bar = b.bar;
        __builtin_amdgcn_s_waitcnt(0);
        unsigned nloc = b.st[0], nx = b.st[1];
        if (nloc == 0u) { xcd_barrier_complete(bar, b.x, nloc, nx); b.st[0] = nloc; b.st[1] = nx; }
        const unsigned old = xb_add(&bar[XB_XSUB(b.x)], 1u);
        const unsigned gen = old / nloc;
        if (old + 1u == (gen + 1u) * nloc) {
            __builtin_amdgcn_fence(__ATOMIC_RELEASE, "");
            asm volatile("s_waitcnt vmcnt(0)" ::: "memory");
            const unsigned og = xb_add(&bar[XB_TOP], 1u);
            const unsigned tg = og / nx;
            if (og + 1u == (tg + 1u) * nx) xb_add(&bar[XB_TOPGEN], 1u);
            else XB_SPIN(xb_ld(&bar[XB_TOPGEN]) == tg, bar);
            __builtin_amdgcn_fence(__ATOMIC_ACQUIRE, "");
            xb_add(&bar[XB_XGEN(b.x)], 1u);
            asm volatile("s_waitcnt vmcnt(0)" ::: "memory");
        } else {
            XB_SPIN(xb_ld(&bar[XB_XGEN(b.x)]) == gen, bar);
            __builtin_amdgcn_fence(__ATOMIC_ACQUIRE, "");
            asm volatile("s_waitcnt vmcnt(0)" ::: "memory");
        }
    }
    __syncthreads();
}

#ifndef GEMM_DRAIN0
#define GEMM_DRAIN0 0
#endif
namespace pg8 {
constexpr int BM = 256, BK = 64, HALF = 128, HTB = HALF * BK * 2, NXCD = 8, WGM = 8;
__device__ __forceinline__ int lds_byte(int r, int c) { const int st = (r >> 4) * 2 + (c >> 5), rr = r & 15, cc = c & 31, ob = rr * 64 + cc * 2; return st * 1024 + (ob ^ (((ob >> 9) & 1) << 5)); }
__device__ __forceinline__ void stage_rc(int b, int& R, int& C) { const int st = b / 1024, sb = b % 1024, swz = sb ^ (((sb >> 9) & 1) << 5); R = (st >> 1) * 16 + swz / 64; C = (st & 1) * 32 + (swz % 64) / 2; }
__device__ __forceinline__ int perm32(int rho) { const int n = rho >> 4, i = rho & 15; return 8 * (i >> 2) + 4 * n + (i & 3); }
struct Unit { int pm, pn, bt; };
__device__ __forceinline__ void tile_of(int L, int nM, int nN, int& pm, int& pn) {
    const int nwg = nM * nN; int wgid = L;
    { const int q = nwg / NXCD, r = nwg % NXCD, xcd = wgid % NXCD, off = wgid / NXCD; wgid = (xcd < r ? xcd * (q + 1) : r * (q + 1) + (xcd - r) * q) + off; }
    const int nig = WGM * nN, gid = wgid / nig, fm = gid * WGM, gsz = (nM - fm) < WGM ? (nM - fm) : WGM;
    pm = fm + ((wgid % nig) % gsz); pn = (wgid % nig) / gsz;
}
struct StaticOrder {
    int nM, nN, nwg, G, c;
    __device__ void init(int M, int N, int G_, int c_) { nM = M / BM; nN = N / BM; nwg = nM * nN; G = G_; c = c_; }
    __device__ __forceinline__ bool next(int i, Unit& u) const {
        const long L = (long)i * G + c; if (L >= nwg) return false;
        tile_of((int)L, nM, nN, u.pm, u.pn); u.bt = u.pn; return true;
    }
};
struct ListOrder {
    const LAS int* ul; int n;
    __device__ __forceinline__ bool next(int i, Unit& u) const {
        if (i >= n) return false;
        u.pm = __builtin_amdgcn_readfirstlane(ul[3 * i]); u.pn = __builtin_amdgcn_readfirstlane(ul[3 * i + 1]); u.bt = __builtin_amdgcn_readfirstlane(ul[3 * i + 2]); return true;
    }
};

template <class Epi, class Sched, bool GATHER>
__device__ __forceinline__ void gemm_phase(LAS unsigned char* lds, const bf16_t* Abase, const bf16_t* Btbase, const int K, const Sched& S, const Epi& E, const LAS unsigned* gtab) {
    const int tid = tid_opaque(), wid = __builtin_amdgcn_readfirstlane(tid >> 6), lane = tid & 63, wr = wid >> 2, wc = wid & 3, fr = lane & 15, fq = lane >> 4;
    const int nt = K / BK;
    unsigned voffA[2], voffB[2]; int RA[2], CA2[2];
#pragma unroll
    for (int i = 0; i < 2; ++i) { int R, C; stage_rc(tid * 16 + i * 8192, R, C); const int Rb = Epi::PERM ? ((R & ~31) + perm32(R & 31)) : R;
        voffA[i] = (unsigned)(R * K + C) * 2u; voffB[i] = (unsigned)(Rb * K + C) * 2u; RA[i] = R; CA2[i] = C * 2; }
    const size_t kstep = (size_t)(BK * 2);
    const size_t hstep = (size_t)HALF * K * 2;
    const size_t tstep = 2 * hstep;
    const unsigned ldsw = (unsigned)wid * 1024u;
    const int aoff = lds_byte(wr * 64 + fr, fq * 8), boff = lds_byte(wc * 32 + fr, fq * 8);
#define PG8_SA(b, h) (((b) * 2 + (h)) * HTB)
#define PG8_SB(b, h) ((4 + (b) * 2 + (h)) * HTB)
#define PG8_STAGE(bufoff, gbase, voff) do { _Pragma("unroll") for (int _i = 0; _i < 2; ++_i) \
        __builtin_amdgcn_global_load_lds((const unsigned*)((const char*)(gbase) + (voff)[_i]), (LAS unsigned*)(lds + (bufoff) + ldsw + _i * 8192), 16, 0, 0); } while (0)
#define PG8_STGA(bufoff, ptr, h, goff) do { if constexpr (GATHER) { PG8_STAGE(bufoff, ptr, goff[h]); } else { PG8_STAGE(bufoff, (ptr) + (h) * hstep, voffA); } } while (0)
#define PG8_LDA(dst, b, h) do { _Pragma("unroll") for (int m = 0; m < 4; ++m) _Pragma("unroll") for (int k = 0; k < 2; ++k) dst[m][k] = *(const LAS bf16x8*)(lds + PG8_SA(b, h) + aoff + m * 2048 + k * 1024); } while (0)
#define PG8_LDB(dst, b, h) do { _Pragma("unroll") for (int n = 0; n < 2; ++n) _Pragma("unroll") for (int k = 0; k < 2; ++k) dst[n][k] = *(const LAS bf16x8*)(lds + PG8_SB(b, h) + boff + n * 2048 + k * 1024); } while (0)
#define PG8_MMA(ai, bj, At, Bt) do { __builtin_amdgcn_s_setprio(1); _Pragma("unroll") for (int m = 0; m < 4; ++m) _Pragma("unroll") for (int n = 0; n < 2; ++n) _Pragma("unroll") for (int k = 0; k < 2; ++k) \
        acc[ai][bj][m][n] = __builtin_amdgcn_mfma_f32_16x16x32_bf16(Bt[n][k], At[m][k], acc[ai][bj][m][n], 0, 0, 0); __builtin_amdgcn_s_setprio(0); } while (0)
#define PG8_WAIT_V(n) asm volatile("s_waitcnt vmcnt(" #n ")" ::: "memory")
#define PG8_WAIT_L(n) asm volatile("s_waitcnt lgkmcnt(" #n ")" ::: "memory")
#define PG8_BAR __builtin_amdgcn_s_barrier()
#define PG8_SCHED __builtin_amdgcn_sched_barrier(0)
    Unit cur, nxt; int ui = 0;
    if (!S.next(0, cur)) return;
    f32x4 acc[2][2][4][2];
#pragma unroll
    for (int a = 0; a < 2; ++a)
#pragma unroll
        for (int b = 0; b < 2; ++b)
#pragma unroll
            for (int m = 0; m < 4; ++m)
#pragma unroll
                for (int n = 0; n < 2; ++n) acc[a][b][m][n] = (f32x4){0.f, 0.f, 0.f, 0.f};
    bf16x8 At[4][2], B0[2][2], B1[2][2];
    unsigned gC[2][2], gN[2][2];
    if constexpr (GATHER) {
#pragma unroll
        for (int h = 0; h < 2; ++h)
#pragma unroll
            for (int i = 0; i < 2; ++i) { gC[h][i] = gtab[0 * 256 + h * HALF + RA[i]] + (unsigned)CA2[i]; gN[h][i] = gC[h][i]; }
    }
    const char* cA = GATHER ? (const char*)Abase : (const char*)Abase + (size_t)cur.pm * tstep; const char* cB = (const char*)Btbase + (size_t)cur.bt * tstep;
    PG8_STAGE(PG8_SB(0, 0), cB, voffB); PG8_STAGE(PG8_SB(0, 1), cB + hstep, voffB); PG8_STGA(PG8_SA(0, 0), cA, 0, gC); PG8_STGA(PG8_SA(0, 1), cA, 1, gC);
    if (wr == 1) PG8_BAR;
#if GEMM_DRAIN0
    PG8_WAIT_V(0); PG8_BAR;
#else
    PG8_WAIT_V(2); PG8_BAR;
#endif
    PG8_STAGE(PG8_SB(1, 0), cB + kstep, voffB); PG8_STGA(PG8_SA(1, 0), cA + kstep, 0, gC); PG8_STAGE(PG8_SB(1, 1), cB + hstep + kstep, voffB);
#if GEMM_DRAIN0
    PG8_WAIT_V(0); PG8_BAR;
#else
    PG8_WAIT_V(6); PG8_BAR;
#endif
    for (;;) {
        const bool has_next = S.next(ui + 1, nxt);
        const char* nA = GATHER ? (const char*)Abase : (has_next ? (const char*)Abase + (size_t)nxt.pm * tstep : cA); const char* nB = has_next ? (const char*)Btbase + (size_t)nxt.bt * tstep : cB;
        if constexpr (GATHER) {
            if (has_next) {
#pragma unroll
                for (int h = 0; h < 2; ++h)
#pragma unroll
                    for (int i = 0; i < 2; ++i) gN[h][i] = gtab[(ui + 1) * 256 + h * HALF + RA[i]] + (unsigned)CA2[i];
            } else {
#pragma unroll
                for (int h = 0; h < 2; ++h)
#pragma unroll
                    for (int i = 0; i < 2; ++i) gN[h][i] = gC[h][i];
            }
        }
        for (int t = 0; t < nt; t += 2) {
            const bool last = (t == nt - 2);
            const char* a1 = cA + (size_t)(t + 1) * kstep;
            const char* a2 = last ? nA : cA + (size_t)(t + 2) * kstep; const char* b2 = last ? nB : cB + (size_t)(t + 2) * kstep;
            const char* a3 = a2 + kstep; const char* b3 = b2 + kstep;
            unsigned g2[2][2];
            if constexpr (GATHER) {
#pragma unroll
                for (int h = 0; h < 2; ++h)
#pragma unroll
                    for (int i = 0; i < 2; ++i) g2[h][i] = last ? gN[h][i] : gC[h][i];
            }
#if GEMM_DRAIN0
            PG8_LDB(B0, 0, 0); PG8_LDB(B1, 0, 1); PG8_SCHED; PG8_LDA(At, 0, 0); PG8_WAIT_V(0); PG8_STGA(PG8_SA(1, 1), a1, 1, gC);
            PG8_WAIT_L(0); PG8_BAR; PG8_MMA(0, 0, At, B0); PG8_MMA(0, 1, At, B1); PG8_BAR; PG8_SCHED;
            PG8_LDA(At, 0, 1); PG8_WAIT_V(0); PG8_STAGE(PG8_SB(0, 0), b2, voffB); PG8_STAGE(PG8_SB(0, 1), b2 + hstep, voffB); PG8_STGA(PG8_SA(0, 0), a2, 0, g2);
            PG8_WAIT_L(0); PG8_BAR; PG8_MMA(1, 0, At, B0); PG8_MMA(1, 1, At, B1); PG8_BAR; PG8_SCHED;
            PG8_LDB(B0, 1, 0); PG8_LDB(B1, 1, 1); PG8_SCHED; PG8_LDA(At, 1, 0); PG8_WAIT_V(0); PG8_STGA(PG8_SA(0, 1), a2, 1, g2);
            PG8_WAIT_L(0); PG8_BAR; PG8_MMA(0, 0, At, B0); PG8_MMA(0, 1, At, B1); PG8_BAR; PG8_SCHED;
            PG8_LDA(At, 1, 1); PG8_WAIT_V(0); PG8_STAGE(PG8_SB(1, 0), b3, voffB); PG8_STAGE(PG8_SB(1, 1), b3 + hstep, voffB); PG8_STGA(PG8_SA(1, 0), a3, 0, g2);
            PG8_WAIT_L(0); PG8_BAR; PG8_MMA(1, 0, At, B0); PG8_MMA(1, 1, At, B1); PG8_BAR; PG8_SCHED;
#else
            PG8_LDB(B0, 0, 0); PG8_LDB(B1, 0, 1); PG8_SCHED; PG8_LDA(At, 0, 0); PG8_STGA(PG8_SA(1, 1), a1, 1, gC);
            PG8_WAIT_V(8); PG8_WAIT_L(0); PG8_BAR; PG8_MMA(0, 0, At, B0); PG8_MMA(0, 1, At, B1); PG8_BAR; PG8_SCHED;
            PG8_LDA(At, 0, 1); PG8_STAGE(PG8_SB(0, 0), b2, voffB); PG8_STAGE(PG8_SB(0, 1), b2 + hstep, voffB); PG8_STGA(PG8_SA(0, 0), a2, 0, g2);
            PG8_WAIT_V(8); PG8_WAIT_L(0); PG8_BAR; PG8_MMA(1, 0, At, B0); PG8_MMA(1, 1, At, B1); PG8_BAR; PG8_SCHED;
            PG8_LDB(B0, 1, 0); PG8_LDB(B1, 1, 1); PG8_SCHED; PG8_LDA(At, 1, 0); PG8_STGA(PG8_SA(0, 1), a2, 1, g2);
            PG8_WAIT_V(8); PG8_WAIT_L(0); PG8_BAR; PG8_MMA(0, 0, At, B0); PG8_MMA(0, 1, At, B1); PG8_BAR; PG8_SCHED;
            PG8_LDA(At, 1, 1); PG8_STAGE(PG8_SB(1, 0), b3, voffB); PG8_STAGE(PG8_SB(1, 1), b3 + hstep, voffB); PG8_STGA(PG8_SA(1, 0), a3, 0, g2);
            PG8_WAIT_V(8); PG8_WAIT_L(0); PG8_BAR; PG8_MMA(1, 0, At, B0); PG8_MMA(1, 1, At, B1); PG8_BAR; PG8_SCHED;
#endif
        }
        if (wr == 0) PG8_BAR;
        E(acc, cur, ui, wr, wc, fr, fq);
        if (!has_next) break;
#pragma unroll
        for (int a = 0; a < 2; ++a)
#pragma unroll
            for (int b = 0; b < 2; ++b)
#pragma unroll
                for (int m = 0; m < 4; ++m)
#pragma unroll
                    for (int n = 0; n < 2; ++n) acc[a][b][m][n] = (f32x4){0.f, 0.f, 0.f, 0.f};
        cur = nxt; cA = nA; cB = nB; ++ui;
        if constexpr (GATHER) {
#pragma unroll
            for (int h = 0; h < 2; ++h)
#pragma unroll
                for (int i = 0; i < 2; ++i) gC[h][i] = gN[h][i];
        }
        if (wr == 1) PG8_BAR;
    }
    PG8_WAIT_V(0);
    PG8_BAR;
#undef PG8_SA
#undef PG8_SB
#undef PG8_STAGE
#undef PG8_STGA
#undef PG8_LDA
#undef PG8_LDB
#undef PG8_MMA
#undef PG8_WAIT_V
#undef PG8_WAIT_L
#undef PG8_BAR
#undef PG8_SCHED
}

typedef f32x4 Acc[2][2][4][2];
template <bool NORMS>
struct EpiRowScaleBf16T {
    static constexpr bool PERM = true;
    bf16_t* O; int ldc; const float* rs; int split_cols; size_t split_stride; unsigned* nrm;
    __device__ __forceinline__ void operator()(const Acc& acc, const Unit& u, int, int wr, int wc, int fr, int fq) const {
        const int row0 = u.pm * BM + wr * 64 + fr; int colt = u.pn * BM; bf16_t* base = O; int tsel = 0;
        if (split_cols) { const int t = colt / split_cols; tsel = t; base += (size_t)t * split_stride; colt -= t * split_cols; }
        const int col0 = colt + wc * 32 + 8 * fq;
        float mx0 = 0.f, mx1 = 0.f;
#pragma unroll
        for (int ai = 0; ai < 2; ++ai)
#pragma unroll
            for (int m = 0; m < 4; ++m) { const int row = row0 + ai * HALF + m * 16; const float s = ld_coh(rs + row); bf16_t* rowp = base + (size_t)row * ldc + col0;
#pragma unroll
                for (int bj = 0; bj < 2; ++bj) { const f32x4 v0 = acc[ai][bj][m][0] * s, v1 = acc[ai][bj][m][1] * s;
                    u32x4 w; w.x = cvt_pk_bf16(v0[0], v0[1]); w.y = cvt_pk_bf16(v0[2], v0[3]); w.z = cvt_pk_bf16(v1[0], v1[1]); w.w = cvt_pk_bf16(v1[2], v1[3]);
                    st16_wt(rowp + bj * HALF, w);
                    if constexpr (NORMS) { float ss = (v0[0] * v0[0] + v0[1] * v0[1]) + (v0[2] * v0[2] + v0[3] * v0[3]) + (v1[0] * v1[0] + v1[1] * v1[1]) + (v1[2] * v1[2] + v1[3] * v1[3]);
                        ss += __shfl_xor(ss, 16); ss += __shfl_xor(ss, 32);
                        if (bj == 0) mx0 = fmaxf(mx0, ss); else mx1 = fmaxf(mx1, ss); } } }
        if constexpr (NORMS) {
            if (tsel < 2) {
#pragma unroll
                for (int o = 1; o < 16; o <<= 1) { mx0 = fmaxf(mx0, __shfl_xor(mx0, o)); mx1 = fmaxf(mx1, __shfl_xor(mx1, o)); }
                if (fr == 0 && fq == 0) { const int b = u.pm >> 4, h = (colt >> 8) & 15; unsigned* p = nrm + (((tsel * 2 + b) * 16 + h) * 2) * 4 + wc;
                    __hip_atomic_fetch_max(p, __builtin_bit_cast(unsigned, mx0), __ATOMIC_RELAXED, __HIP_MEMORY_SCOPE_AGENT);
                    __hip_atomic_fetch_max(p + 4, __builtin_bit_cast(unsigned, mx1), __ATOMIC_RELAXED, __HIP_MEMORY_SCOPE_AGENT); } } }
    }
};
typedef EpiRowScaleBf16T<false> EpiRowScaleBf16;
struct EpiGlu {
    static constexpr bool PERM = false;
    const float* X; float* H;
    __device__ __forceinline__ void operator()(const Acc& acc, const Unit& u, int, int wr, int wc, int fr, int fq) const {
        const int row0 = u.pm * BM + wr * 64 + fr, col0 = u.pn * HALF + wc * 32 + 4 * fq;
#pragma unroll
        for (int ai = 0; ai < 2; ++ai)
#pragma unroll
            for (int m = 0; m < 4; ++m) { const size_t off = (size_t)(row0 + ai * HALF + m * 16) * DM + col0;
#pragma unroll
                for (int n = 0; n < 2; ++n) { const f32x4 a = acc[ai][0][m][n], b = acc[ai][1][m][n]; const f32x4 xv = *(const f32x4*)(X + off + n * 16);
                    f32x4 o; o[0] = xv[0] + a[0] * fast_sigmoid(b[0]); o[1] = xv[1] + a[1] * fast_sigmoid(b[1]); o[2] = xv[2] + a[2] * fast_sigmoid(b[2]); o[3] = xv[3] + a[3] * fast_sigmoid(b[3]);
                    st16_wt(H + off + n * 16, o); } }
    }
};
struct EpiGateUp {
    static constexpr bool PERM = true;
    bf16_t* Hm; const LAS float* tabR; const LAS float* tabW;
    __device__ __forceinline__ void operator()(const Acc& acc, const Unit& u, int ui, int wr, int wc, int fr, int fq) const {
        const int col0 = u.pn * HALF + wc * 32 + 8 * fq;
#pragma unroll
        for (int ai = 0; ai < 2; ++ai)
#pragma unroll
            for (int m = 0; m < 4; ++m) { const int rl = ai * HALF + wr * 64 + m * 16 + fr; const float r = tabR[ui * 256 + rl], w = tabW[ui * 256 + rl];
                float hv[8];
#pragma unroll
                for (int n = 0; n < 2; ++n)
#pragma unroll
                    for (int j = 0; j < 4; ++j) { const float g = acc[ai][0][m][n][j] * r, up = acc[ai][1][m][n][j] * r; hv[n * 4 + j] = g * fast_sigmoid(g) * up * w; }
                u32x4 o; o.x = cvt_pk_bf16(hv[0], hv[1]); o.y = cvt_pk_bf16(hv[2], hv[3]); o.z = cvt_pk_bf16(hv[4], hv[5]); o.w = cvt_pk_bf16(hv[6], hv[7]);
                st16_wt(Hm + (size_t)(u.pm * BM + rl) * FF + col0, o); }
    }
};
struct EpiDown {
    static constexpr bool PERM = true;
    bf16_t* Y; const LAS unsigned* tabD;
    __device__ __forceinline__ void operator()(const Acc& acc, const Unit& u, int ui, int wr, int wc, int fr, int fq) const {
        const int col0 = u.pn * BM + wc * 32 + 8 * fq;
#pragma unroll
        for (int ai = 0; ai < 2; ++ai)
#pragma unroll
            for (int m = 0; m < 4; ++m) { const int rl = ai * HALF + wr * 64 + m * 16 + fr; const unsigned d = tabD[ui * 256 + rl];
                if (d != 0xFFFFFFFFu) { bf16_t* rowp = Y + (size_t)d * DM + col0;
#pragma unroll
                    for (int bj = 0; bj < 2; ++bj) { const f32x4 v0 = acc[ai][bj][m][0], v1 = acc[ai][bj][m][1];
                        u32x4 w; w.x = cvt_pk_bf16(v0[0], v0[1]); w.y = cvt_pk_bf16(v0[2], v0[3]); w.z = cvt_pk_bf16(v1[0], v1[1]); w.w = cvt_pk_bf16(v1[2], v1[3]);
                        st16_wt(rowp + bj * HALF, w); } } }
    }
};
struct EpiResAdd {
    static constexpr bool PERM = false;
    float* H;
    __device__ __forceinline__ void operator()(const Acc& acc, const Unit& u, int, int wr, int wc, int fr, int fq) const {
        const int row0 = u.pm * BM + wr * 64 + fr, col0 = u.pn * BM + wc * 32 + 4 * fq;
#pragma unroll
        for (int ai = 0; ai < 2; ++ai)
#pragma unroll
            for (int m = 0; m < 4; ++m) { float* rowp = H + (size_t)(row0 + ai * HALF + m * 16) * DM + col0;
#pragma unroll
                for (int bj = 0; bj < 2; ++bj)
#pragma unroll
                    for (int n = 0; n < 2; ++n) { f32x4* p = (f32x4*)(rowp + bj * HALF + n * 16); const f32x4 t = *p + acc[ai][bj][m][n]; st16_wt(p, t); } }
    }
};
}

struct Args { const float* in[32]; float* out; unsigned char* ws; int ph_lo, ph_hi; int dbg_kind, dbg_pad; size_t dbg_off; };
typedef const __attribute__((address_space(4))) Args* KArgsPtr;
struct Frame {
    LAS unsigned char* lds; unsigned* ctl;
    int tid, lane, wave, vcu, G, bid;
    unsigned char* ws;
};
__device__ __forceinline__ KArgsPtr launder_args(KArgsPtr kp) { asm volatile("" : "+s"(kp)); return kp; }
__device__ __forceinline__ Frame make_frame(KArgsPtr a, LAS unsigned char* lds) {
    Frame F; { unsigned lb = (unsigned)(uintptr_t)lds; asm volatile("" : "+s"(lb)); F.lds = (LAS unsigned char*)(uintptr_t)lb; } F.tid = tid_opaque(); F.lane = F.tid & 63; F.wave = __builtin_amdgcn_readfirstlane(F.tid >> 6);
    F.G = grid_opaque(); F.bid = bid_opaque(); { const int bx = F.bid; F.vcu = (F.G % 8 == 0) ? (bx % 8) * (F.G / 8) + bx / 8 : bx; }
    F.ws = a->ws; F.ctl = (unsigned*)(F.ws + WS_CTL);
    return F;
}

__device__ __forceinline__ void conv_tile(const float* __restrict__ W, int N, int k0, int n0, const float* __restrict__ gain, int gmask, float gscale,
                                          bf16_t* __restrict__ dst, int ldk, int drow0, LAS unsigned* scr, int lane) {
    const int kk = lane >> 4, nq = lane & 15;
    f32x4 v[16];
#pragma unroll
    for (int i = 0; i < 16; ++i) v[i] = __builtin_nontemporal_load((const f32x4*)(W + (size_t)(k0 + 2 * kk + (i & 1) + 8 * (i >> 1)) * N + n0 + 4 * nq));
#pragma unroll
    for (int ip = 0; ip < 8; ++ip) {
        const int k = k0 + 2 * kk + 8 * ip;
        const float g0 = gain ? gain[k & gmask] * gscale : 1.0f, g1 = gain ? gain[(k + 1) & gmask] * gscale : 1.0f;
#pragma unroll
        for (int j = 0; j < 4; ++j) { const int n = 4 * nq + j; scr[n * 32 + ((kk + 4 * ip) ^ (nq << 1))] = cvt_pk_bf16(v[2 * ip][j] * g0, v[2 * ip + 1][j] * g1); }
    }
    LDS_WAIT();
#pragma unroll
    for (int jj = 0; jj < 8; ++jj) {
        const int n = (lane >> 3) + 8 * jj, c = lane & 7;
        u32x4 w = *(const LAS u32x4*)(scr + n * 32 + 4 * (c ^ jj));
        if ((n >> 2) & 1) w = (u32x4){w.z, w.w, w.x, w.y};
        st16_wt(dst + (size_t)(drow0 + n) * ldk + k0 + 8 * c, w);
    }
    LDS_WAIT();
}
__device__ __forceinline__ int ileave(int n0) { return (n0 >> 7) * 256 + (n0 & 127); }

__device__ __forceinline__ void p0_prologue(Frame& F, KArgsPtr a) {
    LAS unsigned* scr = (LAS unsigned*)(F.lds + F.wave * 8192);
    const int gw = F.vcu * NWAVES + F.wave, NGW = F.G * NWAVES, lane = F.lane;
    unsigned char* ws = F.ws;
    constexpr int T_WIN = 64 * 32, T_GL = 32 * 64, T_SQ = 64 * 64, T_EXP = 3 * 1024;
    constexpr int O_GLA = T_WIN, O_GLB = O_GLA + T_GL, O_Q = O_GLB + T_GL, O_K = O_Q + T_SQ, O_V = O_K + T_SQ, O_O = O_V + T_SQ, O_MOE = O_O + T_SQ, NT_ALL = O_MOE + 32 * T_EXP;
    for (int it = gw; it < NT_ALL; it += NGW) {
        if (it < O_GLA) { const int r = it, kb = r / 32, nb = r % 32;
            conv_tile(a->in[1], SW, kb * 64, nb * 64, a->in[29], -1, 1.f, (bf16_t*)(ws + WS_WIN), DM, nb * 64, scr, lane); }
        else if (it < O_Q) { const int half = it >= O_GLB; const int r = it - (half ? O_GLB : O_GLA), kb = r / 64, nb = r % 64;
            conv_tile(half ? a->in[11] : a->in[10], DM, kb * 64, nb * 64, nullptr, -1, 1.f, (bf16_t*)(ws + WS_GLU), SW, ileave(nb * 64) + half * 128, scr, lane); }
        else if (it < O_O) { const int which = (it - O_Q) / T_SQ; const int r = (it - O_Q) % T_SQ, kb = r / 64, nb = r % 64;
            const float* W = which == 0 ? a->in[15] : (which == 1 ? a->in[13] : a->in[14]); const float* g = which == 0 ? a->in[29] + DM : a->in[12];
            conv_tile(W, AW, kb * 64, nb * 64, g, -1, 1.f, (bf16_t*)(ws + WS_QKV), DM, which * AW + nb * 64, scr, lane); }
        else if (it < O_MOE) { const int r = it - O_O, kb = r / 64, nb = r % 64;
            conv_tile(a->in[21], DM, kb * 64, nb * 64, a->in[20], 255, 1.0f - LAMBDA_INIT1, (bf16_t*)(ws + WS_WO), AW, nb * 64, scr, lane); }
        else { const int r0 = it - O_MOE, le = r0 / T_EXP, r1 = r0 % T_EXP, which = r1 / 1024, r = r1 % 1024, li = le / NE;
            if (which < 2) { const int kb = r / 16, nb = r % 16;
                conv_tile((which ? a->in[27] : a->in[26]) + (size_t)le * DM * FF, FF, kb * 64, nb * 64, a->in[30] + li * DM, -1, 1.f,
                          (bf16_t*)(ws + WS_GU) + (size_t)le * 2048 * DM, DM, ileave(nb * 64) + which * 128, scr, lane); }
            else { const int kb = r / 64, nb = r % 64;
                conv_tile(a->in[28] + (size_t)le * FF * DM, DM, kb * 64, nb * 64, nullptr, -1, 1.f, (bf16_t*)(ws + WS_DN) + (size_t)le * DM * FF, FF, nb * 64, scr, lane); } }
    }
    { float* WrT = (float*)(ws + WS_WRT);
      for (int i = (F.vcu * NWAVES + F.wave) * 64 + lane; i < 2 * 32 * DM; i += NGW * 64) { const int li = i / (32 * DM), c = (i / DM) % 32, k = i % DM; const float g = a->in[30][li * DM + k];
          float v = 0.f; if (c < 4) v = a->in[22][((size_t)li * DM + k) * 4 + c] * g; else if (c < 20) v = a->in[24][((size_t)li * DM + k) * 16 + (c - 4)] * g;
          st4_wt(WrT + i, __builtin_bit_cast(unsigned, v)); } }
    { const float* x = a->in[0]; bf16_t* xb = (bf16_t*)(ws + WS_XB); float* rstd = (float*)(ws + WS_RSTD);
      for (int m = gw; m < T; m += NGW) { const f32x4* xr = (const f32x4*)(x + (size_t)m * DM) + lane; u32x2* o8 = (u32x2*)(xb + (size_t)m * DM) + lane; float s = 0.f;
#pragma unroll
          for (int j = 0; j < 16; ++j) { const f32x4 v = xr[64 * j]; s += (v.x * v.x + v.y * v.y) + (v.z * v.z + v.w * v.w); st8_wt(o8 + 64 * j, (u32x2){cvt_pk_bf16(v.x, v.y), cvt_pk_bf16(v.z, v.w)}); }
          s = wave_sum(s); if (lane == 0) st_coh(rstd + m, 1.0f / sqrtf(s * (1.0f / DM) + EPS)); } }
}

template <bool COMBINE, bool ROUTER>
__device__ __forceinline__ void rn_phase(Frame& F, float* H, const bf16_t* Y, bf16_t* hb, float* rstd, const float* WrT, const float* bgroup, const float* brouter,
                                         unsigned* cnt, int* list_tok, float* list_w) {
    LAS float* pss = (LAS float*)(F.lds);
    LAS float* plg = (LAS float*)(F.lds + 1024);
    const int lane = F.lane, r = lane & 15, kq = lane >> 4, wave = F.wave;
    for (int task = F.vcu; task < T / 16; task += F.G) {
        const int row = task * 16 + r; const size_t rb = (size_t)row * DM + wave * 512 + 4 * kq;
        f32x4 acc0 = {0.f, 0.f, 0.f, 0.f}, acc1 = {0.f, 0.f, 0.f, 0.f}; float ss = 0.f;
        const float* w0p = WrT + (size_t)r * DM + wave * 512 + 4 * kq; const float* w1p = w0p + (size_t)16 * DM;
#pragma unroll 8
        for (int s = 0; s < 32; ++s) {
            f32x4 v = *(const f32x4*)(H + rb + 16 * s);
            if constexpr (COMBINE) { const u32x2 ya = *(const u32x2*)(Y + rb + 16 * s), yb2 = *(const u32x2*)(Y + (size_t)T * DM + rb + 16 * s);
                v.x += bf2f(ya.x & 0xffffu) + bf2f(yb2.x & 0xffffu); v.y += bf2f(ya.x >> 16) + bf2f(yb2.x >> 16); v.z += bf2f(ya.y & 0xffffu) + bf2f(yb2.y & 0xffffu); v.w += bf2f(ya.y >> 16) + bf2f(yb2.y >> 16);
                st16_wt(H + rb + 16 * s, v); }
            ss += (v.x * v.x + v.y * v.y) + (v.z * v.z + v.w * v.w);
            st8_wt(hb + rb + 16 * s, (u32x2){cvt_pk_bf16(v.x, v.y), cvt_pk_bf16(v.z, v.w)});
            if constexpr (ROUTER) { const f32x4 w0 = *(const f32x4*)(w0p + 16 * s), w1 = *(const f32x4*)(w1p + 16 * s);
#pragma unroll
                for (int j = 0; j < 4; ++j) { acc0 = __builtin_amdgcn_mfma_f32_16x16x4f32(v[j], w0[j], acc0, 0, 0, 0); acc1 = __builtin_amdgcn_mfma_f32_16x16x4f32(v[j], w1[j], acc1, 0, 0, 0); } }
        }
        ss += __shfl_xor(ss, 16); ss += __shfl_xor(ss, 32);
        if (kq == 0) pss[wave * 16 + r] = ss;
        if constexpr (ROUTER) {
#pragma unroll
            for (int q = 0; q < 4; ++q) { plg[(wave * 16 + 4 * kq + q) * 32 + r] = acc0[q]; plg[(wave * 16 + 4 * kq + q) * 32 + 16 + r] = acc1[q]; } }
        __syncthreads();
        if (F.tid < 16) { const int t = F.tid, tok = task * 16 + t; float s = 0.f;
#pragma unroll
            for (int w = 0; w < 8; ++w) s += pss[w * 16 + t];
            const float rs = 1.0f / sqrtf(s * (1.0f / DM) + EPS); st_coh(rstd + tok, rs);
            if constexpr (ROUTER) {
                float lg[4];
#pragma unroll
                for (int c = 0; c < 4; ++c) { float q = 0.f;
#pragma unroll
                    for (int w = 0; w < 8; ++w) q += plg[(w * 16 + t) * 32 + c];
                    lg[c] = q * rs + bgroup[c]; }
                int gi = 0; float gm = lg[0];
#pragma unroll
                for (int c = 1; c < 4; ++c) if (lg[c] > gm) { gm = lg[c]; gi = c; }
                float den = 0.f;
#pragma unroll
                for (int c = 0; c < 4; ++c) den += expf(lg[c] - gm);
                const float gval = 1.0f / den;
                float sv[4];
#pragma unroll
                for (int j = 0; j < 4; ++j) { float q = 0.f;
#pragma unroll
                    for (int w = 0; w < 8; ++w) q += plg[(w * 16 + t) * 32 + 4 + 4 * gi + j];
                    sv[j] = q * rs + brouter[4 * gi + j]; }
                int i1 = 0; float v1 = sv[0];
#pragma unroll
                for (int j = 1; j < 4; ++j) if (sv[j] > v1) { v1 = sv[j]; i1 = j; }
                int i2 = -1; float v2 = -3.0e38f;
#pragma unroll
                for (int j = 0; j < 4; ++j) if (j != i1 && sv[j] > v2) { v2 = sv[j]; i2 = j; }
                const float w1 = 1.0f / (1.0f + expf(v2 - v1)), w2 = 1.0f - w1;
                const int e1 = 4 * gi + i1, e2 = 4 * gi + i2;
#ifdef DBG_ROUTE
                { float* dbg = (float*)(F.ws + WS_OB) + (size_t)tok * 4096; for (int q = 0; q < 4096; q += 4) { dbg[q] = (float)e1; dbg[q + 1] = (float)e2; dbg[q + 2] = w1 * gval; dbg[q + 3] = rs; } }
#endif
                const unsigned p1 = __hip_atomic_fetch_add(cnt + e1 * 64, 1u, __ATOMIC_RELAXED, __HIP_MEMORY_SCOPE_AGENT);
                const unsigned p2 = __hip_atomic_fetch_add(cnt + e2 * 64, 1u, __ATOMIC_RELAXED, __HIP_MEMORY_SCOPE_AGENT);
                if (p1 < (unsigned)LISTCAP) { st_coh(list_tok + e1 * LISTCAP + p1, tok * 2); st_coh(list_w + e1 * LISTCAP + p1, w1 * gval); }
                if (p2 < (unsigned)LISTCAP) { st_coh(list_tok + e2 * LISTCAP + p2, tok * 2 + 1); st_coh(list_w + e2 * LISTCAP + p2, w2 * gval); }
            }
        }
        __syncthreads();
    }
}

template <bool DOWN>
__device__ __forceinline__ int build_group(Frame& F, const unsigned* cnt, const int* list_tok, const float* list_w, const float* rstd, int nN, int K2  ) {
    LAS int* ti = (LAS int*)(F.lds + TAB_OFF);
    LAS unsigned* tabA = (LAS unsigned*)(F.lds + TAB_OFF + 256);
    LAS float* tabR = (LAS float*)(F.lds + TAB_OFF + 256 + 8 * 1024);
    LAS float* tabW = (LAS float*)(F.lds + TAB_OFF + 256 + 16 * 1024);
    if (F.tid == 0) {
        int ts = 0;
        for (int e = 0; e < NE; ++e) { ti[8 + e] = ts; const unsigned c = __hip_atomic_load(cnt + e * 64, __ATOMIC_RELAXED, __HIP_MEMORY_SCOPE_AGENT); ts += (int)((c > (unsigned)LISTCAP ? (unsigned)LISTCAP : c) + 255u) >> 8; }
        ti[8 + NE] = ts;
        int n = 0;
        for (int i = 0; n < 8; ++i) { const long L = (long)i * F.G + F.bid; if (L >= (long)ts * nN) break; int pm, pn; pg8::tile_of((int)L, ts, nN, pm, pn);
            int e = 0; while (e < NE - 1 && ti[8 + e + 1] <= pm) ++e;
            ti[32 + 3 * n] = pm; ti[32 + 3 * n + 1] = pn; ti[32 + 3 * n + 2] = e * nN + pn; ++n; }
        ti[0] = n;
    }
    __syncthreads();
    const int n = ti[0];
    for (int i = 0; i < n; ++i) {
        if (F.tid < 256) { const int rr = F.tid, pm = ti[32 + 3 * i], e = ti[32 + 3 * i + 2] / nN, idx = (pm - ti[8 + e]) * 256 + rr;
            unsigned c = __hip_atomic_load(cnt + e * 64, __ATOMIC_RELAXED, __HIP_MEMORY_SCOPE_AGENT); if (c > (unsigned)LISTCAP) c = LISTCAP;
            const bool valid = (unsigned)idx < c;
            int tk = 0; float w = 0.f; if (valid) { tk = ld_coh(list_tok + e * LISTCAP + idx); w = ld_coh(list_w + e * LISTCAP + idx); }
            if constexpr (DOWN) { tabA[i * 256 + rr] = valid ? (unsigned)((tk & 1) * T + (tk >> 1)) : 0xFFFFFFFFu; }
            else { tabA[i * 256 + rr] = (unsigned)(tk >> 1) * (unsigned)K2; tabR[i * 256 + rr] = valid ? ld_coh(rstd + (tk >> 1)) : 0.f; tabW[i * 256 + rr] = w; } }
    }
    __syncthreads();
    return n;
}

__device__ __forceinline__ float gelu_tanh(float y) { const float z = 1.5957691216f * (y + 0.044715f * y * y * y); return y * fast_sigmoid(z); }
struct Cx { float re, im; };
__device__ __forceinline__ Cx cmul(Cx a, Cx b) { return {a.re * b.re - a.im * b.im, a.re * b.im + a.im * b.re}; }
__device__ __forceinline__ Cx cfma(Cx a, Cx b, Cx c) { return {fmaf(a.re, b.re, fmaf(-a.im, b.im, c.re)), fmaf(a.re, b.im, fmaf(a.im, b.re, c.im))}; }
template <int PASS>
__device__ __forceinline__ void scan_task(KArgsPtr a, unsigned char* ws, LAS unsigned char* wlds, int b, int g, int seg, int lane) {
    const int c = lane & 31, hi = lane >> 5; int chkflag = 0; (void)chkflag;
    const bf16_t* ub = (const bf16_t*)(ws + WS_UB); bf16_t* yb = (bf16_t*)(ws + WS_YB); float* ends = (float*)(ws + WS_ENDS);
    const float dt = expf(a->in[4][g]);
    Cx lam[2], lam16[2]; bf16x8 Bre[2], Bim[2];
#pragma unroll
    for (int s = 0; s < 2; ++s) { const int p = c + 32 * s; const float are = a->in[2][g * SP + p], aim = a->in[3][g * SP + p];
        const float mag = expf(are * dt), th = aim * dt; const float lr = mag * __cosf(th), li = mag * __sinf(th);
        lam[s] = {lr, li};
        const float den = are * are + aim * aim, nr = lr - 1.0f; const float qre = (nr * are + li * aim) / den, qim = (li * are - nr * aim) / den;
        const float* brp = a->in[5] + ((size_t)(g * SP + p)) * SJ + 8 * hi; const float* bip = a->in[6] + ((size_t)(g * SP + p)) * SJ + 8 * hi;
        const f32x4 br0 = *(const f32x4*)brp, br1 = *(const f32x4*)(brp + 4), bi0 = *(const f32x4*)bip, bi1 = *(const f32x4*)(bip + 4);
        float vr[8], vi[8];
#pragma unroll
        for (int j = 0; j < 4; ++j) { vr[j] = qre * br0[j] - qim * bi0[j]; vi[j] = qre * bi0[j] + qim * br0[j]; vr[4 + j] = qre * br1[j] - qim * bi1[j]; vi[4 + j] = qre * bi1[j] + qim * br1[j]; }
        u32x4 wr_ = {cvt_pk_bf16(vr[0], vr[1]), cvt_pk_bf16(vr[2], vr[3]), cvt_pk_bf16(vr[4], vr[5]), cvt_pk_bf16(vr[6], vr[7])};
        u32x4 wi_ = {cvt_pk_bf16(vi[0], vi[1]), cvt_pk_bf16(vi[2], vi[3]), cvt_pk_bf16(vi[4], vi[5]), cvt_pk_bf16(vi[6], vi[7])};
        Bre[s] = __builtin_bit_cast(bf16x8, wr_); Bim[s] = __builtin_bit_cast(bf16x8, wi_);
        Cx l2 = cmul(lam[s], lam[s]), l4 = cmul(l2, l2), l8 = cmul(l4, l4); lam16[s] = cmul(l8, l8); }
    Cx carry[2] = {{0.f, 0.f}, {0.f, 0.f}};
    bf16x8 Cf[4]; float dsk = 0.f;
    if constexpr (PASS == 2) {
        Cx lamL[2];
#pragma unroll
        for (int s = 0; s < 2; ++s) { Cx t = lam16[s]; for (int q = 16; q < LSEG; q <<= 1) t = cmul(t, t); lamL[s] = t; }
        for (int sp = 0; sp < seg; ++sp) {
#pragma unroll
            for (int s = 0; s < 2; ++s) { const float* ep = ends + ((size_t)((b * NG + g) * NSEG + sp)) * 128 + 2 * (c + 32 * s); carry[s] = cfma(lamL[s], carry[s], Cx{ld_coh(ep), ld_coh(ep + 1)}); } }
#ifdef DBG_SELFCHK2
        { Cx c2[2] = {{0.f, 0.f}, {0.f, 0.f}};
          for (int sp = 0; sp < seg; ++sp) {
#pragma unroll
            for (int s = 0; s < 2; ++s) { const float* ep = ends + ((size_t)((b * NG + g) * NSEG + sp)) * 128 + 2 * (c + 32 * s); c2[s] = cfma(lamL[s], c2[s], Cx{ld_coh(ep), ld_coh(ep + 1)}); } }
          _Pragma("unroll") for (int s = 0; s < 2; ++s) if (__builtin_bit_cast(unsigned, c2[s].re) != __builtin_bit_cast(unsigned, carry[s].re) || __builtin_bit_cast(unsigned, c2[s].im) != __builtin_bit_cast(unsigned, carry[s].im)) chkflag |= 2; }
#endif
        const int ca = lane & 15, kq = lane >> 4;
#pragma unroll
        for (int ks = 0; ks < 4; ++ks) { const f32x4 cr = *(const f32x4*)(a->in[7] + ((size_t)(g * SJ + ca)) * SP + 16 * ks + 4 * kq), ci = *(const f32x4*)(a->in[8] + ((size_t)(g * SJ + ca)) * SP + 16 * ks + 4 * kq);
            u32x4 w = {cvt_pk_bf16(cr[0], -ci[0]), cvt_pk_bf16(cr[1], -ci[1]), cvt_pk_bf16(cr[2], -ci[2]), cvt_pk_bf16(cr[3], -ci[3])}; Cf[ks] = __builtin_bit_cast(bf16x8, w); }
        dsk = a->in[9][g * SJ + ca];
    }
    const int tl = 16 * ((c >> 2) & 1) + (c & 3) + 4 * (c >> 3);
    LAS unsigned* Xs = (LAS unsigned*)wlds;
    for (int ch = 0; ch < LSEG / 32; ++ch) {
        const int t0 = b * SEQ + seg * LSEG + ch * 32;
        const bf16x8 af = *(const bf16x8*)(ub + (size_t)(t0 + tl) * SW + g * SJ + 8 * hi);
        f32x16 X[2][2];
#pragma unroll
        for (int s = 0; s < 2; ++s) { const f32x16 z = {};
            X[s][0] = __builtin_amdgcn_mfma_f32_32x32x16_bf16(af, Bre[s], z, 0, 0, 0); X[s][1] = __builtin_amdgcn_mfma_f32_32x32x16_bf16(af, Bim[s], z, 0, 0, 0); }
#pragma unroll
        for (int s = 0; s < 2; ++s) {
            Cx x = {0.f, 0.f};
#pragma unroll
            for (int r = 0; r < 16; ++r) { x = cfma(lam[s], x, Cx{X[s][0][r], X[s][1][r]}); X[s][0][r] = x.re; X[s][1][r] = x.im; }
            const Cx eo = {__shfl_xor(x.re, 32), __shfl_xor(x.im, 32)};
            if constexpr (PASS == 1) { const Cx e0 = hi ? eo : x, e1 = hi ? x : eo; carry[s] = cfma(lam16[s], cfma(lam16[s], carry[s], e0), e1); }
            else {
                const Cx cin1 = cfma(lam16[s], carry[s], eo); Cx w = hi ? cin1 : carry[s];
#pragma unroll
                for (int r = 0; r < 16; ++r) { w = cmul(lam[s], w); X[s][0][r] += w.re; X[s][1][r] += w.im; }
                const Cx fin = {X[s][0][15], X[s][1][15]}; const Cx fo = {__shfl_xor(fin.re, 32), __shfl_xor(fin.im, 32)};
                carry[s] = hi ? fin : fo;
#pragma unroll
                for (int r = 0; r < 16; ++r) Xs[(16 * hi + r) * 68 + c + 32 * s] = cvt_pk_bf16(X[s][0][r], X[s][1][r]);
            }
        }
        if constexpr (PASS == 2) {
            LDS_WAIT();
            const int ca = lane & 15, kq = lane >> 4;
#pragma unroll
            for (int rb = 0; rb < 2; ++rb) { f32x4 acc = {0.f, 0.f, 0.f, 0.f}; asm volatile("" : "+v"(acc));
#pragma unroll
                for (int ks = 0; ks < 4; ++ks) { const bf16x8 xf = *(const LAS bf16x8*)(Xs + (16 * rb + ca) * 68 + 16 * ks + 4 * kq); acc = __builtin_amdgcn_mfma_f32_16x16x32_bf16(xf, Cf[ks], acc, 0, 0, 0); }
#ifdef DBG_SELFCHK
                { f32x4 acc2 = {0.f, 0.f, 0.f, 0.f}; asm volatile("" : "+v"(acc2)); LDS_WAIT();
#pragma unroll
                  for (int ks = 0; ks < 4; ++ks) { const bf16x8 xf = *(const LAS bf16x8*)(Xs + (16 * rb + ca) * 68 + 16 * ks + 4 * kq); acc2 = __builtin_amdgcn_mfma_f32_16x16x32_bf16(xf, Cf[ks], acc2, 0, 0, 0); }
                  if (__builtin_bit_cast(unsigned, acc[0]) != __builtin_bit_cast(unsigned, acc2[0]) || __builtin_bit_cast(unsigned, acc[1]) != __builtin_bit_cast(unsigned, acc2[1]) ||
                      __builtin_bit_cast(unsigned, acc[2]) != __builtin_bit_cast(unsigned, acc2[2]) || __builtin_bit_cast(unsigned, acc[3]) != __builtin_bit_cast(unsigned, acc2[3])) chkflag |= 1; }
#endif
#pragma unroll
                for (int q = 0; q < 4; ++q) { const size_t o = (size_t)(t0 + 16 * rb + 4 * kq + q) * SW + g * SJ + ca; const float y = acc[q] + dsk * bf2f(ub[o]); st2_wt(yb + o, f2bf(gelu_tanh(y))); } }
            LDS_WAIT();
        }
    }
#if defined(DBG_SELFCHK) || defined(DBG_SELFCHK2) || defined(DBG_SELFCHK3)
    if constexpr (PASS == 2) { const int any = __any(chkflag != 0); float* dbg = (float*)(ws + WS_OC); if (lane == 0) dbg[(b * NG + g) * NSEG + seg] = any ? 1000.f : 0.f; }
#endif
    if constexpr (PASS == 1) { if (hi == 0) {
#pragma unroll
        for (int s = 0; s < 2; ++s) st8_wt(ends + ((size_t)((b * NG + g) * NSEG + seg)) * 128 + 2 * (c + 32 * s), (u32x2){__builtin_bit_cast(unsigned, carry[s].re), __builtin_bit_cast(unsigned, carry[s].im)}); } }
}
template <int PASS>
__device__ __forceinline__ void scan_phase(Frame& F, KArgsPtr a) {
    const int gw = F.vcu * NWAVES + F.wave, NGW = F.G * NWAVES;
    for (int task = gw; task < BATCH * NG * NSEG; task += NGW) { const int seg = task % NSEG, g = (task / NSEG) % NG, b = task / (NSEG * NG);
        if (PASS == 1 && seg == NSEG - 1) continue;
        scan_task<PASS>(a, F.ws, F.lds + F.wave * 9216, b, g, seg, F.lane); }
}

namespace att {
constexpr int D = 128, PITCH = 4096;
constexpr float SCALE = 0.08838834764831845f;
constexpr float THR = 8.f;
constexpr int NW = 8, QBLK = 32, KVBLK = 64, QB = NW * QBLK;
constexpr int SHM_V = KVBLK * D * 2, SHM_K = KVBLK * D * 2;
constexpr int ATT_LDS = 2 * SHM_V + 2 * SHM_K + NW * 64 * 4;
#define KSWZ(row, colB) ((row) * 256 + ((colB) ^ (((row) & 7) << 4)))
#define SBAR() __builtin_amdgcn_sched_barrier(0)
__device__ __forceinline__ int v_st(int k, int c) { const int kk = (k & ~0xC) | ((k & 4) << 1) | ((k & 8) >> 1); return ((kk >> 3) * 4 + (c >> 5)) * 512 + ((kk & 7) * 32 + (c & 31)) * 2; }
__device__ __forceinline__ int v_rd_base(int lane) { return ((lane & 3) << 3) | (((lane >> 2) & 3) << 6) | (((lane >> 4) & 1) << 5) | (((lane >> 5) & 1) << 8); }
constexpr int v_rd_off(int d0, int ks, int half) { return d0 * 512 + ks * 4096 + half * 2048; }
__device__ __forceinline__ int crow(int r, int hi) { return (r & 3) + 8 * (r >> 2) + 4 * hi; }
__device__ __forceinline__ unsigned cvtpk(float lo, float hi) { unsigned r; asm volatile("v_cvt_pk_bf16_f32 %0, %1, %2" : "=v"(r) : "v"(lo), "v"(hi)); return r; }
__device__ __forceinline__ bf16x8 load8(const bf16_t* p) { return *reinterpret_cast<const bf16x8*>(p); }
__device__ __forceinline__ void mask_tile(f32x16& p0, f32x16& p1, int dq, unsigned W) {
    const float NEG = -__builtin_inff();
#pragma unroll
    for (int r = 0; r < 16; ++r) { const int c = (r & 3) + 8 * (r >> 2);
        if ((unsigned)(dq - c) >= W) p0[r] = NEG;
        if ((unsigned)(dq - c - 32) >= W) p1[r] = NEG; }
}
__device__ __forceinline__ void partialSM(f32x16& p0, f32x16& p1, float& m_reg, float& mn, float& alpha) {
    float pmax = p0[0]; for (int r = 1; r < 16; ++r) pmax = fmaxf(pmax, p0[r]); for (int r = 0; r < 16; ++r) pmax = fmaxf(pmax, p1[r]);
    { auto rr = __builtin_amdgcn_permlane32_swap(__float_as_uint(pmax), __float_as_uint(pmax), false, false);
      pmax = fmaxf(__uint_as_float(rr[0]), __uint_as_float(rr[1])); }
    constexpr float C2 = 1.4426950408889634f * SCALE;
    if (__builtin_expect(__all((pmax - m_reg) * SCALE <= THR), 1)) { mn = m_reg; alpha = 1.f; }
    else { mn = fmaxf(m_reg, pmax); alpha = __builtin_amdgcn_exp2f((m_reg - mn) * C2); m_reg = mn; }
    const float mnL = -mn * C2;
    for (int r = 0; r < 16; ++r) p0[r] = fmaf(p0[r], C2, mnL); for (int r = 0; r < 16; ++r) p1[r] = fmaf(p1[r], C2, mnL);
    for (int r = 0; r < 16; ++r) p0[r] = __builtin_amdgcn_exp2f(p0[r]);
}
__device__ __forceinline__ void finishSM(f32x16& p0, f32x16& p1, float alpha, float& l_reg, bf16x8& pa0, bf16x8& pa1, bf16x8& pa2, bf16x8& pa3) {
    for (int r = 0; r < 16; ++r) p1[r] = __builtin_amdgcn_exp2f(p1[r]);
    float ps = 0; for (int r = 0; r < 16; ++r) ps += p0[r]; for (int r = 0; r < 16; ++r) ps += p1[r];
    { auto rr = __builtin_amdgcn_permlane32_swap(__float_as_uint(ps), __float_as_uint(ps), false, false);
      ps = __uint_as_float(rr[0]) + __uint_as_float(rr[1]); }
    l_reg = l_reg * alpha + ps;
#define PK4(P, B_, OUT) do { unsigned a0 = cvtpk(P[B_+0], P[B_+1]), a1 = cvtpk(P[B_+2], P[B_+3]);                          \
        unsigned b0 = cvtpk(P[B_+4], P[B_+5]), b1 = cvtpk(P[B_+6], P[B_+7]);                                             \
        auto r0 = __builtin_amdgcn_permlane32_swap(a0, b0, false, false); auto r1 = __builtin_amdgcn_permlane32_swap(a1, b1, false, false); \
        u32x4 w = {r0[0], r1[0], r0[1], r1[1]}; OUT = *reinterpret_cast<bf16x8*>(&w); } while (0)
    PK4(p0, 0, pa0); PK4(p0, 8, pa1); PK4(p1, 0, pa2); PK4(p1, 8, pa3);
#undef PK4
}
template <int KB>
__device__ __forceinline__ void qkt(f32x16& p0, f32x16& p1, const char* K_lds, int r32, int hi, const bf16x8* qr, float sl, float tb) {
    { const float sl8 = 8.0f * sl, sl32 = 32.0f * sl;
#pragma unroll
      for (int r = 0; r < 16; ++r) { p0[r] = (r == 0) ? tb : ((r & 3) ? p0[r - 1] + sl : p0[r - 4] + sl8); }
#pragma unroll
      for (int r = 0; r < 16; ++r) p1[r] = p0[r] + sl32; }
    const char* kb[4];
#pragma unroll
    for (int dd = 0; dd < 4; ++dd) kb[dd] = K_lds + KB * SHM_K + KSWZ(r32, (dd * 16 + hi * 8) * 2);
#pragma unroll
    for (int d0 = 0; d0 < 8; ++d0) { const char* a = kb[d0 & 3] + (d0 >> 2) * 128;
        bf16x8 b0 = *reinterpret_cast<const bf16x8*>(a);
        bf16x8 b1 = *reinterpret_cast<const bf16x8*>(a + 32 * 256);
        p0 = __builtin_amdgcn_mfma_f32_32x32x16_bf16(b0, qr[d0], p0, 0, 0, 0);
        p1 = __builtin_amdgcn_mfma_f32_32x32x16_bf16(b1, qr[d0], p1, 0, 0, 0); }
}
template <int VB>
__device__ __forceinline__ void pv_tile(f32x16* o, int vb0, bf16x8 pa0, bf16x8 pa1, bf16x8 pa2, bf16x8 pa3) {
#define TRRD(dst, off) asm volatile("ds_read_b64_tr_b16 %0, %1 offset:%2" : "=&v"(dst) : "v"(vb0), "i"(off) : "memory")
#define PV_D0(d0) do { s16x4 l0, l1, l2, l3, h0, h1, h2, h3; constexpr int b_ = VB * SHM_V + v_rd_off(d0, 0, 0);  \
        TRRD(l0, b_); TRRD(h0, b_ + 2048); TRRD(l1, b_ + 4096); TRRD(h1, b_ + 6144); TRRD(l2, b_ + 8192); TRRD(h2, b_ + 10240); TRRD(l3, b_ + 12288); TRRD(h3, b_ + 14336); \
        asm volatile("s_waitcnt lgkmcnt(0)" ::: "memory"); SBAR();   \
        o[d0] = __builtin_amdgcn_mfma_f32_32x32x16_bf16(pa0, (bf16x8){l0[0], l0[1], l0[2], l0[3], h0[0], h0[1], h0[2], h0[3]}, o[d0], 0, 0, 0);   \
        o[d0] = __builtin_amdgcn_mfma_f32_32x32x16_bf16(pa1, (bf16x8){l1[0], l1[1], l1[2], l1[3], h1[0], h1[1], h1[2], h1[3]}, o[d0], 0, 0, 0);   \
        o[d0] = __builtin_amdgcn_mfma_f32_32x32x16_bf16(pa2, (bf16x8){l2[0], l2[1], l2[2], l2[3], h2[0], h2[1], h2[2], h2[3]}, o[d0], 0, 0, 0);   \
        o[d0] = __builtin_amdgcn_mfma_f32_32x32x16_bf16(pa3, (bf16x8){l3[0], l3[1], l3[2], l3[3], h3[0], h3[1], h3[2], h3[3]}, o[d0], 0, 0, 0); } while (0)
    PV_D0(0); PV_D0(1); PV_D0(2); PV_D0(3);
#undef PV_D0
#undef TRRD
}
struct BlockRef { const bf16_t* Q; const bf16_t* K; const bf16_t* V; bf16_t* O; int P0; float sl; int jlo; };
struct Seam { bf16x8 qr[8]; bf16x8 st_v0, st_v1, st_k0, st_k1; };
#define ROW(p, k0, rr) ((p) + (size_t)((k0) + (rr)) * PITCH + sc)
#define VMW() asm volatile("s_waitcnt vmcnt(0)" ::: "memory")
#define VMWN(n) asm volatile("s_waitcnt vmcnt(%0)" :: "i"(n) : "memory")
#define SLOAD_H(Kp, Vp, k0) do { S.st_v0 = load8(ROW(Vp, k0, sr)); S.st_v1 = load8(ROW(Vp, k0, 32 + sr));              \
                         S.st_k0 = load8(ROW(Kp, k0, sr)); S.st_k1 = load8(ROW(Kp, k0, 32 + sr)); } while (0)
#define SWRITE_HK(bf) do { *(bf16x8*)(K_lds + (bf) * SHM_K + kws) = S.st_k0; *(bf16x8*)(K_lds + (bf) * SHM_K + kws + 32 * 256) = S.st_k1; } while (0)
#define SWRITE_HV(bf) do { *(bf16x8*)(V_lds + (bf) * SHM_V + vst0) = S.st_v0; *(bf16x8*)(V_lds + (bf) * SHM_V + vst1) = S.st_v1; } while (0)
#define SWRITE_H(bf) do { SWRITE_HV(bf); SWRITE_HK(bf); } while (0)
__device__ __forceinline__ void causal_prime(const BlockRef& cur, char* lds, Seam& S) {
    const int tid = tid_opaque(), wid = __builtin_amdgcn_readfirstlane(tid >> 6), lane = tid & 63, r32 = lane & 31, hi = lane >> 5;
    const int sr = tid >> 4, sc = (tid & 15) * 8, kws = KSWZ(sr, sc * 2); char* K_lds = lds + 2 * SHM_V;
    for (int d0 = 0; d0 < 8; ++d0) S.qr[d0] = load8(cur.Q + (size_t)(wid * QBLK + r32) * PITCH + d0 * 16 + hi * 8);
    SLOAD_H(cur.K, cur.V, cur.jlo * KVBLK); VMW(); SWRITE_HK(0);
    __syncthreads();
}
__device__ __forceinline__ void causal_block(const BlockRef& cur, const BlockRef& nxt, char* lds, Seam& S) {
    const int tid = tid_opaque(), wid = __builtin_amdgcn_readfirstlane(tid >> 6), lane = tid & 63, r32 = lane & 31, hi = lane >> 5;
    const int W = SEQ;
    const int j_hi = (cur.P0 + QB - 1) / KVBLK + 1;
    const int j_lo = cur.jlo; const int NT = j_hi - j_lo;
    const int qlo = cur.P0 + wid * QBLK, qm = qlo + r32 - 4 * hi;
    char* V_lds = lds; char* K_lds = lds + 2 * SHM_V;
    float* ws = (float*)(lds + 2 * SHM_V + 2 * SHM_K) + wid * 64; float* li_l = ws, * al_l = ws + 32;
    float m_reg = -1e30f, l_reg = 0; f32x16 o[4] = {};
    const int sr = tid >> 4, sc = (tid & 15) * 8, vst0 = v_st(sr, sc), vst1 = v_st(32 + sr, sc), kws = KSWZ(sr, sc * 2);
    const int vb0 = (int)(uintptr_t)V_lds + v_rd_base(lane);
    const bf16_t* Kh = cur.K; const bf16_t* Vh = cur.V;
    const float sl = cur.sl, tb0 = sl * (float)(4 * hi - cur.P0);
#define RESC(a) do { if (__any((a) < 1.f)) { if (hi == 0) al_l[r32] = (a); asm volatile("s_waitcnt lgkmcnt(0)" ::: "memory");              \
                     for (int d_ = 0; d_ < 4; ++d_) for (int r = 0; r < 16; ++r) o[d_][r] *= al_l[crow(r, hi)]; } } while (0)
#define KBASE(t) ((j_lo + (t)) * KVBLK)
#define TB(t) fmaf(sl, (float)KBASE(t), tb0)
#define MASKT(P0_, P1_, t) do { const int kb_ = KBASE(t); if (kb_ + KVBLK - 1 > qlo) mask_tile(P0_, P1_, qm - kb_, (unsigned)W); } while (0)
    constexpr int NQL = 8;
#define SEAM_K0() do { VMWN(NQL); SWRITE_HK(0); SBAR(); } while (0)
    f32x16 pA0, pA1, pB0, pB1; float mnA, mnB, alA, alB; bf16x8 pa0, pa1, pa2, pa3;
    SWRITE_HV(0); SBAR();
    if (NT > 1) { SLOAD_H(Kh, Vh, KBASE(1)); }
    SBAR(); qkt<0>(pA0, pA1, K_lds, r32, hi, S.qr, sl, TB(0));
    MASKT(pA0, pA1, 0); partialSM(pA0, pA1, m_reg, mnA, alA);
    if (NT > 1) { VMW(); SWRITE_H(1); }
    __syncthreads();
#define HALF_STEP(PX0, PX1, mnX, alX, PY0, PY1, alY, t, KB, VB, SB) do {                                                      \
        SBAR(); qkt<KB>(PX0, PX1, K_lds, r32, hi, S.qr, sl, TB(t));                                             \
        finishSM(PY0, PY1, alY, l_reg, pa0, pa1, pa2, pa3); SBAR();                                                           \
        if ((t) + 1 < NT) { SLOAD_H(Kh, Vh, KBASE((t) + 1)); SBAR(); }                                               \
        pv_tile<VB>(o, vb0, pa0, pa1, pa2, pa3); MASKT(PX0, PX1, (t)); partialSM(PX0, PX1, m_reg, mnX, alX);                                        \
        __syncthreads();                                                                                                      \
        if ((t) + 1 < NT) { VMW(); SWRITE_H(SB); }                                                                          \
        RESC(alX); __syncthreads(); } while (0)
    for (int t = 1; t + 1 < NT; t += 2) {
        HALF_STEP(pB0, pB1, mnB, alB, pA0, pA1, alA, t, 1, 0, 0);
        HALF_STEP(pA0, pA1, mnA, alA, pB0, pB1, alB, t + 1, 0, 1, 1);
    }
    const bool even = (NT & 1) == 0;
    if (even) { SBAR(); qkt<1>(pB0, pB1, K_lds, r32, hi, S.qr, sl, TB(NT - 1)); SBAR(); }
    SLOAD_H(nxt.K, nxt.V, nxt.jlo * KVBLK); SBAR();
#pragma unroll
    for (int d0 = 0; d0 < 8; ++d0) S.qr[d0] = load8(nxt.Q + (size_t)(wid * QBLK + r32) * PITCH + d0 * 16 + hi * 8);
    SBAR();
    finishSM(pA0, pA1, alA, l_reg, pa0, pa1, pa2, pa3); SBAR();
    pv_tile<0>(o, vb0, pa0, pa1, pa2, pa3);
    if (even) { MASKT(pB0, pB1, NT - 1); partialSM(pB0, pB1, m_reg, mnB, alB); __syncthreads(); RESC(alB);
        finishSM(pB0, pB1, alB, l_reg, pa0, pa1, pa2, pa3); SBAR(); pv_tile<1>(o, vb0, pa0, pa1, pa2, pa3); }
    SBAR(); SEAM_K0();
    if (hi == 0) li_l[r32] = l_reg; asm volatile("s_waitcnt lgkmcnt(0)" ::: "memory");
    float rli[16];
#pragma unroll
    for (int r = 0; r < 16; ++r) rli[r] = __builtin_amdgcn_rcpf(li_l[crow(r, hi)]);
    bf16_t* Ow = cur.O + (size_t)(wid * QBLK) * PITCH;
#pragma unroll
    for (int r = 0; r < 16; ++r) { const int orow = crow(r, hi);
#pragma unroll
        for (int d0 = 0; d0 < 4; ++d0) { const float v = o[d0][r] * rli[r];
            const float vn = __shfl_xor(v, 1);
            if ((r32 & 1) == 0) st4_wt(Ow + (size_t)orow * PITCH + d0 * 32 + r32, cvtpk(v, vn)); } }
    __syncthreads();
#undef RESC
#undef KBASE
#undef TB
#undef MASKT
#undef SEAM_K0
#undef HALF_STEP
}
#undef ROW
#undef VMW
#undef VMWN
#undef SLOAD_H
#undef SWRITE_HK
#undef SWRITE_HV
#undef SWRITE_H
#undef KSWZ
#undef SBAR
__device__ __forceinline__ BlockRef make_ref(unsigned char* ws, int hp, int qb) {
    const int vh = hp & 1, c = (hp >> 1) & 1, h = (hp >> 2) & 15, b = hp >> 6;
    const bf16_t* Q = (const bf16_t*)(ws + WS_Q); const bf16_t* Kp = Q + (size_t)T * AW; const bf16_t* Vp = Kp + (size_t)T * AW; bf16_t* O = (bf16_t*)(ws + WS_OC) + (size_t)c * T * AW;
    BlockRef r; const size_t tok0 = (size_t)b * SEQ;
    r.Q = Q + (tok0 + (size_t)qb * QB) * PITCH + h * 256 + c * 128; r.K = Kp + tok0 * PITCH + h * 256 + c * 128; r.V = Vp + tok0 * PITCH + h * 256 + vh * 128;
    r.O = O + (tok0 + (size_t)qb * QB) * PITCH + h * 256 + vh * 128; r.P0 = qb * QB;
    const float slope = exp2f(-0.5f * (float)(h + 1));
    r.sl = slope * (1.0f / SCALE);
    const unsigned* nq = (const unsigned*)(ws + WS_CTL) + CW_NRM + (((0 * 2 + b) * 16 + h) * 2 + c) * 4; const unsigned* nk = nq + 2 * 16 * 2 * 4;
    float q2 = 0.f, k2 = 0.f;
#pragma unroll
    for (int w = 0; w < 4; ++w) { q2 += __builtin_bit_cast(float, __hip_atomic_load(nq + w, __ATOMIC_RELAXED, __HIP_MEMORY_SCOPE_AGENT)); k2 += __builtin_bit_cast(float, __hip_atomic_load(nk + w, __ATOMIC_RELAXED, __HIP_MEMORY_SCOPE_AGENT)); }
    const float qk = sqrtf(q2 * k2) * 1.02f;
    const float wreq = (110.0f + 2.0f * SCALE * qk) / slope;
    const float jf = ceilf(((float)r.P0 - wreq - 63.0f) * (1.0f / 64.0f));
    r.jlo = jf > 0.f ? (int)jf : 0;
    return r;
}
__device__ __forceinline__ int item_hp(int bid, int i, int G, int& x) {
    if (G == 256) { const int g = bid >> 6, r = bid & 63; x = r & 7; const int vh = (r >> 3) & 1, c = (r >> 4) & 1, b = r >> 5;
        const int h = i == 0 ? g : (i == 1 ? 7 - g : (i == 2 ? 8 + g : 12 + g));
        return ((b * 16 + h) * 2 + c) * 2 + vh; }
    const int L = bid + i * G; x = L & 7; return L >> 3;
}
__device__ __forceinline__ void attn_phase(unsigned char* ws, char* lds, int G, int bid) {
    constexpr int NQB = SEQ / QB, TOTAL = (NQB / 2) * 128;
    const int nitems = (G == 256) ? 4 : (bid < TOTAL ? (TOTAL - bid + G - 1) / G : 0);
    if (nitems == 0) return;
    int it = 0, pass = 0, x; int hp = item_hp(bid, 0, G, x);
    BlockRef cur = make_ref(ws, hp, x);
    Seam S;
    causal_prime(cur, lds, S);
    for (;;) {
        const bool more_pass = pass == 0, more_item = it + 1 < nitems, last = !more_pass && !more_item;
        int itn = it, passn = pass + 1, hpn = hp, xn = x;
        if (!more_pass) { passn = 0; if (more_item) { itn = it + 1; hpn = item_hp(bid, itn, G, xn); } }
        const BlockRef nxt = last ? cur : make_ref(ws, hpn, passn ? NQB - 1 - xn : xn);
        causal_block(cur, nxt, lds, S);
        if (last) break;
        cur = nxt; pass = passn; it = itn; hp = hpn; x = xn;
    }
}
}

__device__ __forceinline__ void diff_phase(Frame& F, KArgsPtr a) {
    const int lane = F.lane, gw = F.vcu * NWAVES + F.wave, NGW = F.G * NWAVES;
    float d1 = a->in[16][lane] * a->in[17][lane] + a->in[16][lane + 64] * a->in[17][lane + 64];
    float d2 = a->in[18][lane] * a->in[19][lane] + a->in[18][lane + 64] * a->in[19][lane + 64];
    const float lam = expf(wave_sum(d1)) - expf(wave_sum(d2)) + LAMBDA_INIT1;
    const bf16_t* O0 = (const bf16_t*)(F.ws + WS_OC); const bf16_t* O1 = O0 + (size_t)T * AW; bf16_t* ob = (bf16_t*)(F.ws + WS_OB);
    for (int m = gw; m < T; m += NGW) {
        const size_t base = (size_t)m * AW + 64 * lane; float v[64]; float ss = 0.f;
#pragma unroll
        for (int j = 0; j < 8; ++j) { const u32x4 x0 = *(const u32x4*)(O0 + base + 8 * j), x1 = *(const u32x4*)(O1 + base + 8 * j);
#pragma unroll
            for (int q = 0; q < 4; ++q) { const float lo = bf2f(x0[q] & 0xffffu) - lam * bf2f(x1[q] & 0xffffu), hi2 = bf2f(x0[q] >> 16) - lam * bf2f(x1[q] >> 16);
                v[8 * j + 2 * q] = lo; v[8 * j + 2 * q + 1] = hi2; ss += lo * lo + hi2 * hi2; } }
        ss += __shfl_xor(ss, 1); ss += __shfl_xor(ss, 2);
        const float rs = 1.0f / sqrtf(ss * (1.0f / 256.0f) + EPS);
#pragma unroll
        for (int j = 0; j < 8; ++j) { u32x4 w; w.x = cvt_pk_bf16(v[8 * j] * rs, v[8 * j + 1] * rs); w.y = cvt_pk_bf16(v[8 * j + 2] * rs, v[8 * j + 3] * rs);
            w.z = cvt_pk_bf16(v[8 * j + 4] * rs, v[8 * j + 5] * rs); w.w = cvt_pk_bf16(v[8 * j + 6] * rs, v[8 * j + 7] * rs); st16_wt(ob + base + 8 * j, w); }
    }
}
__device__ __forceinline__ void final_phase(Frame& F, KArgsPtr a) {
    const int lane = F.lane, gw = F.vcu * NWAVES + F.wave, NGW = F.G * NWAVES;
    const float* H = (const float*)(F.ws + WS_H); const bf16_t* Y = (const bf16_t*)(F.ws + WS_YS); const float* g = a->in[31];
    for (int m = gw; m < T; m += NGW) {
        const size_t base = (size_t)m * DM + 4 * lane; f32x4 v[16]; float ss = 0.f;
#pragma unroll
        for (int j = 0; j < 16; ++j) { f32x4 x = *(const f32x4*)(H + base + 256 * j); const u32x2 ya = *(const u32x2*)(Y + base + 256 * j), yb2 = *(const u32x2*)(Y + (size_t)T * DM + base + 256 * j);
            x.x += bf2f(ya.x & 0xffffu) + bf2f(yb2.x & 0xffffu); x.y += bf2f(ya.x >> 16) + bf2f(yb2.x >> 16); x.z += bf2f(ya.y & 0xffffu) + bf2f(yb2.y & 0xffffu); x.w += bf2f(ya.y >> 16) + bf2f(yb2.y >> 16);
            v[j] = x; ss += (x.x * x.x + x.y * x.y) + (x.z * x.z + x.w * x.w); }
        const float rs = 1.0f / sqrtf(wave_sum(ss) * (1.0f / DM) + EPS);
#pragma unroll
        for (int j = 0; j < 16; ++j) { const f32x4 gg = *(const f32x4*)(g + 4 * lane + 256 * j); *(f32x4*)(a->out + base + 256 * j) = v[j] * rs * gg; }
    }
}

constexpr int NPHASE = 17;
#ifndef DBG_ROW_WORDS
#define DBG_ROW_WORDS 1024
#endif
#ifndef DBG_COL_LO
#define DBG_COL_LO 0
#define DBG_COL_HI 4096
#endif
#ifndef PHASE_MASK
#define PHASE_MASK 0x1FFFF
#endif
#define PH_BEGIN KArgsPtr a = launder_args(kp); Frame F = make_frame(a, lds); unsigned char* ws = F.ws; (void)ws; (void)F;
__device__ __forceinline__ void ph_u_gemm(KArgsPtr kp, LAS unsigned char* lds) { PH_BEGIN
    pg8::StaticOrder S; S.init(T, SW, F.G, F.bid);
    pg8::EpiRowScaleBf16 E{(bf16_t*)(ws + WS_UB), SW, (const float*)(ws + WS_RSTD), 0, 0, nullptr};
    pg8::gemm_phase<pg8::EpiRowScaleBf16, pg8::StaticOrder, false>(lds, (const bf16_t*)(ws + WS_XB), (const bf16_t*)(ws + WS_WIN), DM, S, E, nullptr); }
__device__ __forceinline__ void ph_glu_gemm(KArgsPtr kp, LAS unsigned char* lds) { PH_BEGIN
    pg8::StaticOrder S; S.init(T, 2 * DM, F.G, F.bid);
    pg8::EpiGlu E{a->in[0], (float*)(ws + WS_H)};
    pg8::gemm_phase<pg8::EpiGlu, pg8::StaticOrder, false>(lds, (const bf16_t*)(ws + WS_YB), (const bf16_t*)(ws + WS_GLU), SW, S, E, nullptr); }
__device__ __forceinline__ void ph_qkv_gemm(KArgsPtr kp, LAS unsigned char* lds) { PH_BEGIN
    pg8::StaticOrder S; S.init(T, 3 * AW, F.G, F.bid);
    pg8::EpiRowScaleBf16T<true> E{(bf16_t*)(ws + WS_Q), AW, (const float*)(ws + WS_RSTD), AW, (size_t)T * AW, F.ctl + CW_NRM};
    pg8::gemm_phase<pg8::EpiRowScaleBf16T<true>, pg8::StaticOrder, false>(lds, (const bf16_t*)(ws + WS_XB), (const bf16_t*)(ws + WS_QKV), DM, S, E, nullptr); }
__device__ __forceinline__ void ph_wo_gemm(KArgsPtr kp, LAS unsigned char* lds) { PH_BEGIN
    pg8::StaticOrder S; S.init(T, DM, F.G, F.bid);
    pg8::EpiResAdd E{(float*)(ws + WS_H)};
    pg8::gemm_phase<pg8::EpiResAdd, pg8::StaticOrder, false>(lds, (const bf16_t*)(ws + WS_OB), (const bf16_t*)(ws + WS_WO), AW, S, E, nullptr); }
__device__ __forceinline__ void ph_router(KArgsPtr kp, LAS unsigned char* lds, int li) { PH_BEGIN
    rn_phase<false, true>(F, (float*)(ws + WS_H), nullptr, (bf16_t*)(ws + WS_XB), (float*)(ws + WS_RSTD), (const float*)(ws + WS_WRT) + (size_t)li * 32 * DM, a->in[23] + li * 4, a->in[25] + li * NE,
                          F.ctl + CW_CNT + li * NE * 64, (int*)(ws + WS_LIST), (float*)(ws + WS_LIST + 512 * 1024)); }
__device__ __forceinline__ void ph_combine(KArgsPtr kp, LAS unsigned char* lds) { PH_BEGIN
    rn_phase<true, false>(F, (float*)(ws + WS_H), (const bf16_t*)(ws + WS_YS), (bf16_t*)(ws + WS_XB), (float*)(ws + WS_RSTD), nullptr, nullptr, nullptr, nullptr, nullptr, nullptr); }
__device__ __forceinline__ void ph_gateup(KArgsPtr kp, LAS unsigned char* lds, int li) { PH_BEGIN
    const int n = build_group<false>(F, F.ctl + CW_CNT + li * NE * 64, (const int*)(ws + WS_LIST), (const float*)(ws + WS_LIST + 512 * 1024), (const float*)(ws + WS_RSTD), 8, DM * 2);
    pg8::ListOrder S{(const LAS int*)(lds + TAB_OFF + 128), n};
    pg8::EpiGateUp E{(bf16_t*)(ws + WS_HM), (const LAS float*)(lds + TAB_OFF + 256 + 8 * 1024), (const LAS float*)(lds + TAB_OFF + 256 + 16 * 1024)};
    pg8::gemm_phase<pg8::EpiGateUp, pg8::ListOrder, true>(lds, (const bf16_t*)(ws + WS_XB), (const bf16_t*)(ws + WS_GU) + (size_t)li * NE * 2048 * DM, DM, S, E, (const LAS unsigned*)(lds + TAB_OFF + 256)); }
__device__ __forceinline__ void ph_down(KArgsPtr kp, LAS unsigned char* lds, int li) { PH_BEGIN
    const int n = build_group<true>(F, F.ctl + CW_CNT + li * NE * 64, (const int*)(ws + WS_LIST), (const float*)(ws + WS_LIST + 512 * 1024), (const float*)(ws + WS_RSTD), 16, 0);
    pg8::ListOrder S{(const LAS int*)(lds + TAB_OFF + 128), n};
    pg8::EpiDown E{(bf16_t*)(ws + WS_YS), (const LAS unsigned*)(lds + TAB_OFF + 256)};
    pg8::gemm_phase<pg8::EpiDown, pg8::ListOrder, false>(lds, (const bf16_t*)(ws + WS_HM), (const bf16_t*)(ws + WS_DN) + (size_t)li * NE * DM * FF, FF, S, E, nullptr); }
__device__ __forceinline__ void ph_prologue(KArgsPtr kp, LAS unsigned char* lds) { PH_BEGIN p0_prologue(F, a); }
__device__ __forceinline__ void ph_scan1(KArgsPtr kp, LAS unsigned char* lds) { PH_BEGIN
    scan_phase<1>(F, a); }
__device__ __forceinline__ void ph_scan2(KArgsPtr kp, LAS unsigned char* lds) { PH_BEGIN scan_phase<2>(F, a); }
__device__ __forceinline__ void ph_attn(KArgsPtr kp, LAS unsigned char* lds) { PH_BEGIN att::attn_phase(ws, (char*)lds, F.G, F.bid); }
__device__ __forceinline__ void ph_diff(KArgsPtr kp, LAS unsigned char* lds) { PH_BEGIN diff_phase(F, a); }
__device__ __forceinline__ void ph_final(KArgsPtr kp, LAS unsigned char* lds) { PH_BEGIN final_phase(F, a); }

__device__ __forceinline__ void ph_debug(KArgsPtr kp0, LAS unsigned char* lds) {
    KArgsPtr kp = launder_args(kp0);

        XcdBarrier b; b.bar = (unsigned*)(kp->ws + WS_CTL) + CW_BAR; b.x = xb_xcc_id(); b.st = (volatile LAS unsigned*)(lds + MISC_OFF) + 8; xcd_barrier(b);
        const int dtid = tid_opaque(), dbid = bid_opaque(), dgrid = grid_opaque();
        if (kp->dbg_kind == 12) { const float* dbg = (const float*)(kp->ws + WS_OC); float* o12 = kp->out; _Pragma("nounroll") for (size_t i = (size_t)dbid * 512 + dtid; i < (size_t)T * DM; i += (size_t)dgrid * 512) o12[i] = dbg[i & 2047]; return; }
        if (kp->dbg_kind == 10) {
            const int lane = dtid & 63, gw = dbid * 8 + (dtid >> 6), ngw = dgrid * 8; float* o10 = kp->out;
            _Pragma("nounroll") for (int r = gw; r < T; r += ngw) { const unsigned* p = (const unsigned*)(kp->ws + kp->dbg_off) + (size_t)r * DBG_ROW_WORDS; unsigned c = 0;
                _Pragma("nounroll") for (int j = lane; j < DBG_ROW_WORDS; j += 64) { const unsigned w = p[j]; c += (w ^ (w >> 16)) * 2654435761u; c = (c << 5) | (c >> 27); }
                for (int off2 = 1; off2 < 64; off2 <<= 1) c += __shfl_xor(c, off2);
                const float v = (float)(c & 0xFFFFu);
                _Pragma("nounroll") for (int j = lane; j < DM; j += 64) o10[(size_t)r * DM + j] = v; }
            return; }
        const size_t n = (size_t)T * DM; float* o = kp->out;
        _Pragma("nounroll") for (size_t i = (size_t)dbid * 512 + dtid; i < n; i += (size_t)dgrid * 512) {
            if (kp->dbg_kind == 9) { o[i] = (float)(((const unsigned*)kp->in[0])[i] & 0xFFFFu); }
            else if (kp->dbg_kind == 7) { o[i] = (float)(((const unsigned*)(kp->ws + kp->dbg_off))[i] & 0xFFFFu); }
            else if (kp->dbg_kind == 6) { o[i] = ((const float*)(kp->ws + WS_H))[i] - kp->in[0][i]; }
            else if (kp->dbg_kind == 5) { const bf16_t* q = (const bf16_t*)(kp->ws + WS_Q); o[i] = bf2f(q[i]) + 2.f * bf2f(q[i + n]) + 4.f * bf2f(q[i + 2 * n]); }
            else if (kp->dbg_kind == 4) { const int col = (int)(i % DM); o[i] = (col >= DBG_COL_LO && col < DBG_COL_HI) ? bf2f(((const bf16_t*)(kp->ws + kp->dbg_off))[i]) : 0.f; }
            else if (kp->dbg_kind == 1) o[i] = bf2f(((const bf16_t*)(kp->ws + kp->dbg_off))[i]); else o[i] = ((const float*)(kp->ws + kp->dbg_off))[i]; }

}
__device__ __forceinline__ bool ph_in(KArgsPtr kp, int k) { asm volatile("" : "+s"(kp)); return kp->ph_lo <= k && k < kp->ph_hi; }
__device__ __forceinline__ void ph_seam(KArgsPtr kp, LAS unsigned char* lds, int k) {
    asm volatile("" : "+s"(kp));
    if (kp->ph_lo <= k && k + 1 < kp->ph_hi) { XcdBarrier b; b.bar = (unsigned*)(kp->ws + WS_CTL) + CW_BAR; b.x = xb_xcc_id(); b.st = (volatile LAS unsigned*)(lds + MISC_OFF) + 8; xcd_barrier(b);
#ifdef DOUBLE_BARRIER
        for (int extra = 1; extra < DOUBLE_BARRIER; ++extra) xcd_barrier(b);
#endif
    }
}
__global__ void __launch_bounds__(NWAVES * 64, 2) yoco_fwd(Args args) {
    extern __shared__ __attribute__((aligned(16))) unsigned char lds_raw[];
    LAS unsigned char* lds = (LAS unsigned char*)lds_raw;
    KArgsPtr kp = (KArgsPtr)__builtin_amdgcn_kernarg_segment_ptr();
#ifdef DBG_DELAY_TICKS
    { const unsigned long long t0 = __builtin_amdgcn_s_memrealtime(); while (__builtin_amdgcn_s_memrealtime() - t0 < (unsigned long long)DBG_DELAY_TICKS) __builtin_amdgcn_s_sleep(10); }
#endif
    { volatile LAS unsigned* MISC = (volatile LAS unsigned*)(lds + MISC_OFF);
      if (threadIdx.x < 64) MISC[threadIdx.x] = 0u;
      __syncthreads();
      (void)xcd_barrier_post((unsigned*)(args.ws + WS_CTL) + CW_BAR, MISC + 8); }
#ifndef PH_REPEAT_MASK
#define PH_REPEAT_MASK 0
#endif
#define IN(k) (((PHASE_MASK >> ((k) & 31)) & 1) && ph_in(kp, (k)))
#define REP(k) (((PH_REPEAT_MASK >> ((k) & 31)) & 1) && ph_in(kp, (k)))
#define SEAM(k) ph_seam(kp, lds, (k))
    if (IN(0)) ph_prologue(kp, lds); if (REP(0)) { __syncthreads(); ph_prologue(kp, lds); } SEAM(0);
    if (IN(1)) ph_u_gemm(kp, lds); if (REP(1)) { __syncthreads(); ph_u_gemm(kp, lds); } SEAM(1);
    if (IN(2)) ph_scan1(kp, lds); SEAM(2);
    if (IN(3)) ph_scan2(kp, lds); if (REP(3)) { __syncthreads(); ph_scan2(kp, lds); } SEAM(3);
    if (IN(4)) ph_glu_gemm(kp, lds); if (REP(4)) { __syncthreads(); ph_glu_gemm(kp, lds); } SEAM(4);
    if (IN(5)) ph_router(kp, lds, 0); SEAM(5);
    if (IN(6)) ph_gateup(kp, lds, 0); if (REP(6)) { __syncthreads(); ph_gateup(kp, lds, 0); } SEAM(6);
    if (IN(7)) ph_down(kp, lds, 0); if (REP(7)) { __syncthreads(); ph_down(kp, lds, 0); } SEAM(7);
    if (IN(8)) ph_combine(kp, lds); SEAM(8);
    if (IN(9)) ph_qkv_gemm(kp, lds); if (REP(9)) { __syncthreads(); ph_qkv_gemm(kp, lds); } SEAM(9);
    if (IN(10)) ph_attn(kp, lds); if (REP(10)) { __syncthreads(); ph_attn(kp, lds); } SEAM(10);
    if (IN(11)) ph_diff(kp, lds); if (REP(11)) { __syncthreads(); ph_diff(kp, lds); } SEAM(11);
    if (IN(12)) ph_wo_gemm(kp, lds); SEAM(12);
    if (IN(13)) ph_router(kp, lds, 1); SEAM(13);
    if (IN(14)) ph_gateup(kp, lds, 1); SEAM(14);
    if (IN(15)) ph_down(kp, lds, 1); SEAM(15);
    if (IN(16)) ph_final(kp, lds);
    if (kp->dbg_kind) ph_debug(kp, lds);
#undef IN
#undef SEAM
}

#ifndef MK_N_LAUNCHES
#define MK_N_LAUNCHES 1
#endif
extern "C" void kernel_launch(void* const* d_in, const int* in_sizes, int n_in, void* d_out, int out_size, void* d_ws, size_t ws_size, hipStream_t stream) {
    static int grid = 0;
    if (grid == 0) {
        if (n_in != 32 || out_size != T * DM || ws_size < WS_END) { fprintf(stderr, "kernel_launch: unexpected shapes (n_in %d out %d ws %zu)\n", n_in, out_size, ws_size); grid = -1; return; }
        int dev = 0, cus = 0, per_cu = 0;
        if (hipGetDevice(&dev) != hipSuccess || hipDeviceGetAttribute(&cus, hipDeviceAttributeMultiprocessorCount, dev) != hipSuccess) { grid = -1; return; }
        if (hipFuncSetAttribute((const void*)yoco_fwd, hipFuncAttributeMaxDynamicSharedMemorySize, LDS_BYTES) != hipSuccess) { fprintf(stderr, "kernel_launch: hipFuncSetAttribute failed\n"); grid = -1; return; }
        if (hipOccupancyMaxActiveBlocksPerMultiprocessor(&per_cu, (const void*)yoco_fwd, NWAVES * 64, LDS_BYTES) != hipSuccess || per_cu < 1) fprintf(stderr, "kernel_launch: occupancy query says %d\n", per_cu);
        (void)hipGetLastError();
        grid = cus;
    }
    if (grid < 0) return;
    (void)hipMemsetAsync((char*)d_ws + WS_CTL, 0, CTL_ZERO_BYTES, stream);
#ifdef DBG_ZERO_YS
    (void)hipMemsetAsync((char*)d_ws + WS_YS, 0, (size_t)2 * T * DM * 2, stream);
#endif
    Args a{};
    for (int i = 0; i < 32; ++i) a.in[i] = (const float*)d_in[i];
    a.out = (float*)d_out; a.ws = (unsigned char*)d_ws;
#ifdef DBG_STOP
    a.ph_lo = 0; a.ph_hi = DBG_STOP + 1; a.dbg_kind = DBG_KIND; a.dbg_off = (size_t)DBG_OFF_MIB * MiB;
    hipLaunchKernelGGL(yoco_fwd, dim3(grid), dim3(NWAVES * 64), LDS_BYTES, stream, a);
#elif MK_N_LAUNCHES == 1
    a.ph_lo = 0; a.ph_hi = NPHASE;
    hipLaunchKernelGGL(yoco_fwd, dim3(grid), dim3(NWAVES * 64), LDS_BYTES, stream, a);
#else
    for (int p = 0; p < NPHASE; ++p) { a.ph_lo = p; a.ph_hi = p + 1; hipLaunchKernelGGL(yoco_fwd, dim3(grid), dim3(NWAVES * 64), LDS_BYTES, stream, a); }
#endif
}
```
